# Optimizing an MI355X kernel written in HIP

```python
import jax, jax.numpy as jnp
from jax import lax
import numpy as np

D_MODEL = 1024
BATCH = 8
SEQ = 2048
DEPTH = 2

PLE_DIM = 256
HEAD_DIM = 64
SB_WIDTH = D_MODEL // 4
SB_HEADS = SB_WIDTH // HEAD_DIM
MLA_WIDTH = D_MODEL // 2
MLA_HEADS = MLA_WIDTH // HEAD_DIM
MLA_NOPE_DIM = 64
MLA_ROPE_DIM = 32
MLA_V_DIM = HEAD_DIM
MLA_Q_RANK = 384
MLA_KV_RANK = 256
CONV_WIDTH = D_MODEL // 4
CONV_K = 3
MIX_WIDTH = SB_WIDTH + MLA_WIDTH + CONV_WIDTH
IN_SIZES = (SB_WIDTH, SB_WIDTH, SB_WIDTH,
            MLA_Q_RANK, MLA_KV_RANK, MLA_ROPE_DIM,
            CONV_WIDTH, CONV_WIDTH, CONV_WIDTH)
IN_WIDTH = sum(IN_SIZES)
D_FF = 2816
Q_BLOCK = 128
ROPE_BASE = 10000.0
EPS = 1e-6
NEG_INF = -1e30

kernel_name = "hybrid_sb_mla_shortconv_macaron"


def rmsnorm(x, g):
    xf = x.astype(jnp.float32)
    y = xf * lax.rsqrt(jnp.mean(xf * xf, axis=-1, keepdims=True) + EPS)
    return (y * g.astype(jnp.float32)).astype(x.dtype)


def swiglu(x, w_gate, w_up, w_down):
    return (jax.nn.silu(x @ w_gate) * (x @ w_up)) @ w_down


def rope(x, pos):
    half = x.shape[-1] // 2
    inv = ROPE_BASE ** (-jnp.arange(half, dtype=jnp.float32) / half)
    ang = pos.astype(jnp.float32)[..., None] * inv
    cos = jnp.cos(ang)[:, :, None, :]
    sin = jnp.sin(ang)[:, :, None, :]
    xf = x.astype(jnp.float32)
    x1, x2 = xf[..., :half], xf[..., half:]
    return jnp.concatenate([x1 * cos - x2 * sin, x2 * cos + x1 * sin], axis=-1).astype(x.dtype)


def stick_breaking_attention(q, k, v):
    S = q.shape[1]
    scale = q.shape[-1] ** -0.5
    outs = []
    for start in range(0, S, Q_BLOCK):
        end = start + Q_BLOCK
        z = jnp.einsum("bqhd,bkhd->bhqk", q[:, start:end], k[:, :end],
                       preferred_element_type=jnp.float32) * scale
        t_idx = start + jnp.arange(Q_BLOCK)[:, None]
        s_idx = jnp.arange(end)[None, :]
        mask = s_idx < t_idx
        log_not = jnp.where(mask, -jax.nn.softplus(z), 0.0)
        after = lax.cumsum(log_not, axis=3, reverse=True) - log_not
        w = jnp.where(mask, jnp.exp(jax.nn.log_sigmoid(z) + after), 0.0)
        outs.append(jnp.einsum("bhqk,bkhd->bqhd", w.astype(v.dtype), v[:, :end]))
    return jnp.concatenate(outs, axis=1)


def latent_attention(c_q, c_kv, k_rope_raw, pos, g_q, g_kv, w_uq, w_ukv):
    B, S = c_q.shape[0], c_q.shape[1]
    q = (rmsnorm(c_q, g_q) @ w_uq).reshape(B, S, MLA_HEADS, MLA_NOPE_DIM + MLA_ROPE_DIM)
    q_nope, q_rope = q[..., :MLA_NOPE_DIM], rope(q[..., MLA_NOPE_DIM:], pos)
    kv = (rmsnorm(c_kv, g_kv) @ w_ukv).reshape(B, S, MLA_HEADS, MLA_NOPE_DIM + MLA_V_DIM)
    k_nope, v = kv[..., :MLA_NOPE_DIM], kv[..., MLA_NOPE_DIM:]
    k_rope = rope(k_rope_raw[:, :, None, :], pos)[:, :, 0, :]
    scale = (MLA_NOPE_DIM + MLA_ROPE_DIM) ** -0.5
    outs = []
    for start in range(0, S, Q_BLOCK):
        end = start + Q_BLOCK
        sc = (jnp.einsum("bqhd,bkhd->bhqk", q_nope[:, start:end], k_nope[:, :end],
                         preferred_element_type=jnp.float32)
              + jnp.einsum("bqhr,bkr->bhqk", q_rope[:, start:end], k_rope[:, :end],
                           preferred_element_type=jnp.float32)) * scale
        mask = jnp.arange(end)[None, :] <= (start + jnp.arange(Q_BLOCK)[:, None])
        w = jax.nn.softmax(jnp.where(mask, sc, NEG_INF), axis=-1)
        outs.append(jnp.einsum("bhqk,bkhd->bqhd", w.astype(v.dtype), v[:, :end]))
    return jnp.concatenate(outs, axis=1)


def short_gated_conv(b_gate, c_gate, h, w_conv):
    u = c_gate * h
    y = lax.conv_general_dilated(u, w_conv[:, None, :].astype(u.dtype), window_strides=(1,),
                                 padding=[(CONV_K - 1, 0)],
                                 dimension_numbers=("NWC", "WIO", "NWC"),
                                 feature_group_count=u.shape[-1])
    return b_gate * y


def setup_inputs(seed: int = 0) -> dict:
    key = jax.random.key(seed)
    ks = iter(jax.random.split(key, 32))

    def dense(shape, fan_in):
        return jax.random.normal(next(ks), shape, jnp.float32) * fan_in ** -0.5

    def gain(dim):
        return 1.0 + 0.05 * jax.random.normal(next(ks), (DEPTH, dim), jnp.float32)

    x = jax.random.normal(next(ks), (BATCH, SEQ, D_MODEL), jnp.float32)
    p = jax.random.normal(next(ks), (DEPTH, BATCH, SEQ, PLE_DIM), jnp.float32)
    offsets = jax.random.randint(next(ks), (BATCH, 1), 0, 1024, dtype=jnp.int32)
    positions = offsets + jnp.arange(SEQ, dtype=jnp.int32)[None, :]
    return {
        "x": x, "p": p, "positions": positions,
        "g_ffn1_pre": gain(D_MODEL),
        "w1_gate": dense((DEPTH, D_MODEL, D_FF), D_MODEL),
        "w1_up": dense((DEPTH, D_MODEL, D_FF), D_MODEL),
        "w1_down": dense((DEPTH, D_FF, D_MODEL), D_FF),
        "g_ffn1_post": gain(D_MODEL),
        "g_mix_pre": gain(D_MODEL),
        "w_in": dense((DEPTH, D_MODEL, IN_WIDTH), D_MODEL),
        "g_mla_q": gain(MLA_Q_RANK),
        "w_mla_uq": dense((DEPTH, MLA_Q_RANK, MLA_HEADS * (MLA_NOPE_DIM + MLA_ROPE_DIM)), MLA_Q_RANK),
        "g_mla_kv": gain(MLA_KV_RANK),
        "w_mla_ukv": dense((DEPTH, MLA_KV_RANK, MLA_HEADS * (MLA_NOPE_DIM + MLA_V_DIM)), MLA_KV_RANK),
        "w_conv": dense((DEPTH, CONV_K, CONV_WIDTH), CONV_K),
        "w_out": dense((DEPTH, MIX_WIDTH, D_MODEL), MIX_WIDTH),
        "g_mix_post": gain(D_MODEL),
        "g_ffn2_pre": gain(D_MODEL),
        "w2_gate": dense((DEPTH, D_MODEL, D_FF), D_MODEL),
        "w2_up": dense((DEPTH, D_MODEL, D_FF), D_MODEL),
        "w2_down": dense((DEPTH, D_FF, D_MODEL), D_FF),
        "g_ffn2_post": gain(D_MODEL),
        "g_ple_pre": gain(D_MODEL),
        "w_ple_gate": dense((DEPTH, D_MODEL, D_MODEL), D_MODEL),
        "w_ple_proj": dense((DEPTH, PLE_DIM, D_MODEL), PLE_DIM),
        "g_ple_post": gain(D_MODEL),
    }


def reference(x, p, positions, g_ffn1_pre, w1_gate, w1_up, w1_down, g_ffn1_post,
              g_mix_pre, w_in, g_mla_q, w_mla_uq, g_mla_kv, w_mla_ukv, w_conv, w_out,
              g_mix_post, g_ffn2_pre, w2_gate, w2_up, w2_down, g_ffn2_post,
              g_ple_pre, w_ple_gate, w_ple_proj, g_ple_post):
    B, S = x.shape[0], x.shape[1]
    split_at = [int(i) for i in np.cumsum(IN_SIZES)[:-1]]
    for i in range(DEPTH):
        h = rmsnorm(x, g_ffn1_pre[i])
        x = x + 0.5 * rmsnorm(swiglu(h, w1_gate[i], w1_up[i], w1_down[i]), g_ffn1_post[i])

        h = rmsnorm(x, g_mix_pre[i])
        (sb_q, sb_k, sb_v, c_q, c_kv, k_rope_raw,
         cv_b, cv_c, cv_h) = jnp.split(h @ w_in[i], split_at, axis=-1)
        heads = lambda t: t.reshape(B, S, SB_HEADS, HEAD_DIM)
        y_sb = stick_breaking_attention(heads(sb_q), heads(sb_k), heads(sb_v))
        y_mla = latent_attention(c_q, c_kv, k_rope_raw, positions, g_mla_q[i], g_mla_kv[i],
                                 w_mla_uq[i], w_mla_ukv[i])
        y_cv = short_gated_conv(cv_b, cv_c, cv_h, w_conv[i])
        mixed = jnp.concatenate([y_sb.reshape(B, S, SB_WIDTH),
                                 y_mla.reshape(B, S, MLA_WIDTH), y_cv], axis=-1) @ w_out[i]
        x = x + rmsnorm(mixed, g_mix_post[i])

        h = rmsnorm(x, g_ffn2_pre[i])
        x = x + 0.5 * rmsnorm(swiglu(h, w2_gate[i], w2_up[i], w2_down[i]), g_ffn2_post[i])

        h = rmsnorm(x, g_ple_pre[i])
        e = jax.nn.sigmoid(h @ w_ple_gate[i]) * (p[i].astype(x.dtype) @ w_ple_proj[i])
        x = x + rmsnorm(e, g_ple_post[i])
    return x
```

```cpp
#include <hip/hip_runtime.h>
#include <cstdio>
#include <cstdint>
#include <cmath>

typedef unsigned short bf16;
typedef short bf16x8 __attribute__((ext_vector_type(8)));
typedef float f32x4 __attribute__((ext_vector_type(4)));
typedef unsigned u32x4 __attribute__((ext_vector_type(4)));
typedef unsigned u32x2 __attribute__((ext_vector_type(2)));

constexpr int BATCH = 8, SEQ = 2048, T = BATCH * SEQ, D = 1024, FF = 2816, DEPTH = 2;
constexpr int NGU = 2 * FF;
constexpr int NIN = 2304;
constexpr int IN_SBQ = 0, IN_SBK = 256, IN_SBV = 512, IN_CQ = 768, IN_KR = 1152, IN_CKV = 1280, IN_CVB = 1536, IN_CVC = 1792, IN_CVH = 2048;
constexpr int QRANK = 384, KVRANK = 256, NQ = 768, NKV = 1024, PLE = 256;
constexpr float EPS = 1e-6f;

constexpr size_t MiB = 1u << 20;
constexpr size_t WS_CTL = 0;
constexpr size_t WS_SSQ = 1 * MiB;
constexpr size_t WS_SSKV = WS_SSQ + 2 * T * 4;
constexpr size_t WS_ROPE = 2 * MiB;
constexpr size_t WS_W = 4 * MiB;
constexpr size_t WO_GU1 = 0, WO_D1 = WO_GU1 + (size_t)NGU * D, WO_GU2 = WO_D1 + (size_t)D * FF, WO_D2 = WO_GU2 + (size_t)NGU * D,
                 WO_IN = WO_D2 + (size_t)D * FF, WO_UQ = WO_IN + (size_t)NIN * D, WO_UKV = WO_UQ + (size_t)NQ * QRANK,
                 WO_OUT = WO_UKV + (size_t)NKV * KVRANK, WO_PG = WO_OUT + (size_t)D * D, WO_PP = WO_PG + (size_t)D * D,
                 W_LAYER = WO_PP + (size_t)D * PLE;
constexpr size_t WS_HM = 92 * MiB;
constexpr size_t WS_KR = 124 * MiB;
constexpr size_t WS_REG = 125 * MiB;
constexpr size_t WS_IN = WS_REG, WS_QM = WS_REG + 72 * MiB, WS_KV = WS_REG + 96 * MiB;
constexpr size_t WS_HID = WS_REG, WS_Y = WS_REG + 88 * MiB, WS_P16 = WS_REG + 120 * MiB;
constexpr size_t WS_PP = WS_REG;
constexpr size_t WS_END = WS_REG + 128 * MiB;
static_assert(WS_W + 2 * W_LAYER * 2 <= WS_HM, "weights fit");

__device__ __forceinline__ unsigned f2bf(float f) { unsigned u = __float_as_uint(f); return (u + 0x7fffu + ((u >> 16) & 1u)) >> 16; }
__device__ __forceinline__ unsigned pk2(float lo, float hi) { return f2bf(lo) | (f2bf(hi) << 16); }
__device__ __forceinline__ float bf2f(unsigned short b) { return __uint_as_float((unsigned)b << 16); }
__device__ __forceinline__ float wave_sum(float v) {
#pragma unroll
    for (int o = 1; o < 64; o <<= 1) v += __shfl_xor(v, o);
    return v;
}

enum { MAP_ID = 0, MAP_GATE, MAP_UP, MAP_IN, MAP_UQ, MAP_UKV };
__device__ __forceinline__ int dmap(int kind, int c) {
    switch (kind) {
        case MAP_GATE: return 256 * (c >> 7) + (c & 127);
        case MAP_UP:   return 256 * (c >> 7) + 128 + (c & 127);
        case MAP_IN:   return c < 1152 ? c : (c < 1408 ? IN_CKV + (c - 1152) : (c < 1440 ? IN_KR + (c - 1408) : IN_CVB + (c - 1440)));
        case MAP_UQ:   { const int h = c / 96, d = c % 96; return d < 64 ? 64 * h + d : (d < 80 ? 512 + 16 * h + (d - 64) : 640 + 16 * h + (d - 80)); }
        case MAP_UKV:  { const int h = c >> 7, d = c & 127; return d < 64 ? 64 * h + d : 512 + 64 * h + (d - 64); }
        default: return c;
    }
}
__device__ __forceinline__ void prep_item(const float* W, int K, int Nsrc, bf16* WT, int kind, const float* gain, float* scr, int item, int lane) {
    const int nblk = Nsrc / 32, kb = item / nblk, nb = item % nblk, k0 = 64 * kb, n0 = 32 * nb;
#pragma unroll 8
    for (int i = 0; i < 32; ++i) { const int kk = 2 * i + (lane >> 5); float v = W[(size_t)(k0 + kk) * Nsrc + n0 + (lane & 31)]; if (gain) v *= gain[k0 + kk]; scr[kk * 33 + (lane & 31)] = v; }
    __builtin_amdgcn_s_waitcnt(0xc07f); __builtin_amdgcn_wave_barrier();
    const int c = lane & 7;
#pragma unroll
    for (int j = 0; j < 4; ++j) { const int n = (lane >> 3) + 8 * j; const float* s = scr + (8 * c) * 33 + n;
        u32x4 o; o.x = pk2(s[0 * 33], s[1 * 33]); o.y = pk2(s[2 * 33], s[3 * 33]); o.z = pk2(s[4 * 33], s[5 * 33]); o.w = pk2(s[6 * 33], s[7 * 33]);
        *(u32x4*)(WT + (size_t)dmap(kind, n0 + n) * K + k0 + 8 * c) = o; }
    __builtin_amdgcn_s_waitcnt(0xc07f); __builtin_amdgcn_wave_barrier();
}

struct Ptrs {
    const float* x; const float* p; const int* pos;
    const float *g_ffn1_pre, *w1_gate, *w1_up, *w1_down, *g_ffn1_post, *g_mix_pre, *w_in, *g_mla_q, *w_mla_uq, *g_mla_kv, *w_mla_ukv, *w_conv, *w_out,
                *g_mix_post, *g_ffn2_pre, *w2_gate, *w2_up, *w2_down, *g_ffn2_post, *g_ple_pre, *w_ple_gate, *w_ple_proj, *g_ple_post;
    float* out; unsigned char* ws;
};

__device__ __forceinline__ void norm_row_first(const float* xrow, float* Xrow, bf16* hrow, const float* g, int lane) {
    f32x4 v[4]; float s = 0.f;
#pragma unroll
    for (int j = 0; j < 4; ++j) { v[j] = *(const f32x4*)(xrow + 4 * lane + 256 * j); s += (v[j].x * v[j].x + v[j].y * v[j].y) + (v[j].z * v[j].z + v[j].w * v[j].w); }
    const float r = 1.0f / sqrtf(wave_sum(s) * (1.f / D) + EPS);
#pragma unroll
    for (int j = 0; j < 4; ++j) { *(f32x4*)(Xrow + 4 * lane + 256 * j) = v[j]; const f32x4 gg = *(const f32x4*)(g + 4 * lane + 256 * j);
        u32x2 o; o.x = pk2(v[j].x * r * gg.x, v[j].y * r * gg.y); o.y = pk2(v[j].z * r * gg.z, v[j].w * r * gg.w); *(u32x2*)(hrow + 4 * lane + 256 * j) = o; }
}
__device__ __forceinline__ void norm_row_step(const bf16* yrow, float* Xrow, bf16* hrow, float w, const float* g_post, const float* g_next, int lane) {
    f32x4 y[4], x[4]; float s = 0.f;
#pragma unroll
    for (int j = 0; j < 4; ++j) { const u32x2 u = *(const u32x2*)(yrow + 4 * lane + 256 * j);
        y[j].x = __uint_as_float(u.x << 16); y[j].y = __uint_as_float(u.x & 0xffff0000u); y[j].z = __uint_as_float(u.y << 16); y[j].w = __uint_as_float(u.y & 0xffff0000u);
        s += (y[j].x * y[j].x + y[j].y * y[j].y) + (y[j].z * y[j].z + y[j].w * y[j].w); }
    const float r = w / sqrtf(wave_sum(s) * (1.f / D) + EPS); float s2 = 0.f;
#pragma unroll
    for (int j = 0; j < 4; ++j) { const f32x4 gg = *(const f32x4*)(g_post + 4 * lane + 256 * j); x[j] = *(const f32x4*)(Xrow + 4 * lane + 256 * j);
        x[j].x += y[j].x * r * gg.x; x[j].y += y[j].y * r * gg.y; x[j].z += y[j].z * r * gg.z; x[j].w += y[j].w * r * gg.w;
        *(f32x4*)(Xrow + 4 * lane + 256 * j) = x[j]; s2 += (x[j].x * x[j].x + x[j].y * x[j].y) + (x[j].z * x[j].z + x[j].w * x[j].w); }
    if (g_next) { const float r2 = 1.0f / sqrtf(wave_sum(s2) * (1.f / D) + EPS);
#pragma unroll
        for (int j = 0; j < 4; ++j) { const f32x4 gg = *(const f32x4*)(g_next + 4 * lane + 256 * j);
            u32x2 o; o.x = pk2(x[j].x * r2 * gg.x, x[j].y * r2 * gg.y); o.y = pk2(x[j].z * r2 * gg.z, x[j].w * r2 * gg.w); *(u32x2*)(hrow + 4 * lane + 256 * j) = o; } }
}

__global__ void __launch_bounds__(256) k_prep(Ptrs P) {
    __shared__ float scr_all[4][64 * 33];
    const int lane = threadIdx.x & 63, wv = threadIdx.x >> 6; float* scr = scr_all[wv];
    const int gw = blockIdx.x * 4 + wv, NGW = gridDim.x * 4;
    bf16* WB = (bf16*)(P.ws + WS_W);
    constexpr int I_G = (D / 64) * (FF / 32), I_D = (FF / 64) * (D / 32), I_IN = (D / 64) * (2208 / 32), I_UQ = (QRANK / 64) * (NQ / 32), I_UKV = (KVRANK / 64) * (NKV / 32),
                  I_O = (D / 64) * (D / 32), I_PP = (PLE / 64) * (D / 32);
    constexpr int I_LAYER = 6 * I_G + I_IN + I_UQ + I_UKV + 2 * I_O + I_PP;
    static_assert(I_G == I_D, "items");
    for (int it = gw; it < DEPTH * I_LAYER; it += NGW) {
        const int l = it / I_LAYER; int r = it % I_LAYER; bf16* wl = WB + (size_t)l * W_LAYER;
        const size_t oFF = (size_t)l * D * FF;
        if (r < I_G) { prep_item(P.w1_gate + oFF, D, FF, wl + WO_GU1, MAP_GATE, nullptr, scr, r, lane); continue; } r -= I_G;
        if (r < I_G) { prep_item(P.w1_up + oFF, D, FF, wl + WO_GU1, MAP_UP, nullptr, scr, r, lane); continue; } r -= I_G;
        if (r < I_D) { prep_item(P.w1_down + oFF, FF, D, wl + WO_D1, MAP_ID, nullptr, scr, r, lane); continue; } r -= I_D;
        if (r < I_G) { prep_item(P.w2_gate + oFF, D, FF, wl + WO_GU2, MAP_GATE, nullptr, scr, r, lane); continue; } r -= I_G;
        if (r < I_G) { prep_item(P.w2_up + oFF, D, FF, wl + WO_GU2, MAP_UP, nullptr, scr, r, lane); continue; } r -= I_G;
        if (r < I_D) { prep_item(P.w2_down + oFF, FF, D, wl + WO_D2, MAP_ID, nullptr, scr, r, lane); continue; } r -= I_D;
        if (r < I_IN) { prep_item(P.w_in + (size_t)l * D * 2208, D, 2208, wl + WO_IN, MAP_IN, nullptr, scr, r, lane); continue; } r -= I_IN;
        if (r < I_UQ) { prep_item(P.w_mla_uq + (size_t)l * QRANK * NQ, QRANK, NQ, wl + WO_UQ, MAP_UQ, P.g_mla_q + l * QRANK, scr, r, lane); continue; } r -= I_UQ;
        if (r < I_UKV) { prep_item(P.w_mla_ukv + (size_t)l * KVRANK * NKV, KVRANK, NKV, wl + WO_UKV, MAP_UKV, P.g_mla_kv + l * KVRANK, scr, r, lane); continue; } r -= I_UKV;
        if (r < I_O) { prep_item(P.w_out + (size_t)l * D * D, D, D, wl + WO_OUT, MAP_ID, nullptr, scr, r, lane); continue; } r -= I_O;
        if (r < I_O) { prep_item(P.w_ple_gate + (size_t)l * D * D, D, D, wl + WO_PG, MAP_ID, nullptr, scr, r, lane); continue; } r -= I_O;
        prep_item(P.w_ple_proj + (size_t)l * PLE * D, PLE, D, wl + WO_PP, MAP_ID, nullptr, scr, r, lane);
    }
    { const int gt = blockIdx.x * 256 + threadIdx.x, NT = gridDim.x * 256;
      for (int i = gt; i < DEPTH * 96 * (D / 8); i += NT) { const int l = i / (96 * (D / 8)), r = i % (96 * (D / 8)); *(u32x4*)(WB + (size_t)l * W_LAYER + WO_IN + (size_t)(1184 + r / (D / 8)) * D + (r % (D / 8)) * 8) = (u32x4){0u, 0u, 0u, 0u}; }
      float* rt = (float*)(P.ws + WS_ROPE);
      for (int i = gt; i < T * 16; i += NT) { const int t = i >> 4, j = i & 15; const double inv = pow(10000.0, -(double)j / 16.0); const double a = (double)P.pos[t] * inv; rt[t * 32 + j] = (float)cos(a); rt[t * 32 + 16 + j] = (float)sin(a); }
      float* ss = (float*)(P.ws + WS_SSQ);
      for (int i = gt; i < 4 * T; i += NT) ss[i] = 0.f; }
    bf16* HM = (bf16*)(P.ws + WS_HM);
    for (int m = gw; m < T; m += NGW) norm_row_first(P.x + (size_t)m * D, P.out + (size_t)m * D, HM + (size_t)m * D, P.g_ffn1_pre, lane);
}

__global__ void __launch_bounds__(256) k_norm_step(const bf16* Y, float* X, bf16* HM, float w, const float* g_post, const float* g_next) {
    const int lane = threadIdx.x & 63, gw = blockIdx.x * 4 + (threadIdx.x >> 6), NGW = gridDim.x * 4;
    for (int m = gw; m < T; m += NGW) norm_row_step(Y + (size_t)m * D, X + (size_t)m * D, HM + (size_t)m * D, w, g_post, g_next, lane);
}

struct GArgs { const bf16* A; int lda; const bf16* Bt; int ldb; int K; void* C; int ldc; const float* aux; float auxdim; };
template <int MODE> __global__ void __launch_bounds__(256) k_gemm(GArgs g) {
    __shared__ __attribute__((aligned(16))) bf16 sA[64][40];
    __shared__ __attribute__((aligned(16))) bf16 sB[64][40];
    const int tid = threadIdx.x, lane = tid & 63, wv = tid >> 6;
    const int m0 = blockIdx.y * 64;
    const int nbase = (MODE == 1) ? 256 * (blockIdx.x >> 2) + 32 * (blockIdx.x & 3) : blockIdx.x * 64;
#define NB(i) (nbase + ((MODE == 1) ? (((i) >> 1) * 128 + ((i) & 1) * 16) : 16 * (i)))
    f32x4 acc[4];
#pragma unroll
    for (int i = 0; i < 4; ++i) acc[i] = (f32x4){0.f, 0.f, 0.f, 0.f};
    const int sr = tid >> 2, sc = (tid & 3) * 8;
    const bf16* ap = g.A + (size_t)(m0 + sr) * g.lda + sc;
    const bf16* bp = g.Bt + (size_t)(NB(sr >> 4) + (sr & 15)) * g.ldb + sc;
    for (int k0 = 0; k0 < g.K; k0 += 32) {
        const u32x4 va = *(const u32x4*)(ap + k0), vb = *(const u32x4*)(bp + k0);
        __syncthreads();
        *(u32x4*)&sA[sr][sc] = va; *(u32x4*)&sB[sr][sc] = vb;
        __syncthreads();
        const bf16x8 a = *(const bf16x8*)&sA[16 * wv + (lane & 15)][8 * (lane >> 4)];
#pragma unroll
        for (int i = 0; i < 4; ++i) { const bf16x8 b = *(const bf16x8*)&sB[16 * i + (lane & 15)][8 * (lane >> 4)]; acc[i] = __builtin_amdgcn_mfma_f32_16x16x32_bf16(a, b, acc[i], 0, 0, 0); }
    }
#pragma unroll
    for (int r = 0; r < 4; ++r) {
        const int row = m0 + 16 * wv + 4 * (lane >> 4) + r;
        if (MODE == 1) {
#pragma unroll
            for (int i = 0; i < 2; ++i) { const float gv = acc[i][r], uv = acc[i + 2][r]; const float hv = gv / (1.f + __expf(-gv)) * uv;
                const int hcol = 128 * (blockIdx.x >> 2) + 32 * (blockIdx.x & 3) + 16 * i + (lane & 15); ((bf16*)g.C)[(size_t)row * g.ldc + hcol] = (bf16)f2bf(hv); }
        } else {
            float sc2 = 1.f; if (MODE == 2) sc2 = 1.0f / sqrtf(g.aux[row] / g.auxdim + EPS);
#pragma unroll
            for (int i = 0; i < 4; ++i) { const int col = NB(i) + (lane & 15); float v = acc[i][r];
                if (MODE == 0) ((bf16*)g.C)[(size_t)row * g.ldc + col] = (bf16)f2bf(v);
                if (MODE == 2) ((bf16*)g.C)[(size_t)row * g.ldc + col] = (bf16)f2bf(v * sc2);
                if (MODE == 3) ((float*)g.C)[(size_t)row * g.ldc + col] = v;
                if (MODE == 4) { const float e = g.aux[(size_t)row * D + col] / (1.f + __expf(-v)); ((bf16*)g.C)[(size_t)row * g.ldc + col] = (bf16)f2bf(e); } }
        }
    }
}

__global__ void __launch_bounds__(256) k_rowss(const bf16* IN, float* ssq, float* sskv) {
    const int lane = threadIdx.x & 63, gw = blockIdx.x * 4 + (threadIdx.x >> 6), NGW = gridDim.x * 4;
    for (int m = gw; m < T; m += NGW) { const bf16* r = IN + (size_t)m * NIN; float a = 0.f, b = 0.f;
        for (int c = lane; c < QRANK; c += 64) { const float v = bf2f(r[IN_CQ + c]); a += v * v; }
        for (int c = lane; c < KVRANK; c += 64) { const float v = bf2f(r[IN_CKV + c]); b += v * v; }
        a = wave_sum(a); b = wave_sum(b); if (lane == 0) { ssq[m] = a; sskv[m] = b; } }
}
__global__ void __launch_bounds__(256) k_mix_elem(const bf16* IN, const float* rt, const float* wconv, bf16* KR, bf16* HM) {
    const int gt = blockIdx.x * 256 + threadIdx.x, NT = gridDim.x * 256;
    for (int i = gt; i < T * 16; i += NT) { const int t = i >> 4, j = i & 15; const float c = rt[t * 32 + j], s = rt[t * 32 + 16 + j];
        const float x1 = bf2f(IN[(size_t)t * NIN + IN_KR + j]), x2 = bf2f(IN[(size_t)t * NIN + IN_KR + 16 + j]);
        KR[t * 32 + j] = (bf16)f2bf(x1 * c - x2 * s); KR[t * 32 + 16 + j] = (bf16)f2bf(x2 * c + x1 * s); }
    for (int i = gt; i < T * 256; i += NT) { const int t = i >> 8, c = i & 255, tt = t % SEQ; const bf16* r = IN + (size_t)t * NIN; float acc = 0.f;
#pragma unroll
        for (int j = 0; j < 3; ++j) { const int dt = 2 - j; if (tt - dt >= 0) { const bf16* rr = r - (size_t)dt * NIN; acc += wconv[j * 256 + c] * (bf2f(rr[IN_CVC + c]) * bf2f(rr[IN_CVH + c])); } }
        HM[(size_t)t * D + 768 + c] = (bf16)f2bf(bf2f(r[IN_CVB + c]) * acc); }
}
__global__ void __launch_bounds__(256) k_rope_q(bf16* QM, const float* rt) {
    const int gt = blockIdx.x * 256 + threadIdx.x, NT = gridDim.x * 256;
    for (int i = gt; i < T * 128; i += NT) { const int t = i >> 7, c = i & 127, j = c & 15; const float cs = rt[t * 32 + j], sn = rt[t * 32 + 16 + j];
        bf16* q = QM + (size_t)t * NQ; const float x1 = bf2f(q[512 + c]), x2 = bf2f(q[640 + c]);
        q[512 + c] = (bf16)f2bf(x1 * cs - x2 * sn); q[640 + c] = (bf16)f2bf(x2 * cs + x1 * sn); }
}
__global__ void __launch_bounds__(256) k_cvt_p(const float* p, bf16* P16) {
    const int gt = blockIdx.x * 256 + threadIdx.x, NT = gridDim.x * 256;
    for (int i = gt; i < T * PLE / 4; i += NT) { const f32x4 v = *(const f32x4*)(p + 4 * (size_t)i); u32x2 o; o.x = pk2(v.x, v.y); o.y = pk2(v.z, v.w); *(u32x2*)(P16 + 4 * (size_t)i) = o; }
}

__global__ void __launch_bounds__(256) k_sb_attn(const bf16* IN, bf16* HM) {
    const int b = blockIdx.z, h = blockIdx.y, t = blockIdx.x * 256 + threadIdx.x;
    const bf16* base = IN + (size_t)b * SEQ * NIN;
    float q[64], o[64];
    { const bf16* qr = base + (size_t)t * NIN + IN_SBQ + 64 * h;
#pragma unroll
      for (int d = 0; d < 64; ++d) { q[d] = bf2f(qr[d]) * 0.125f; o[d] = 0.f; } }
    const int tmax = __builtin_amdgcn_readfirstlane(blockIdx.x * 256 + (threadIdx.x | 63));
    float after = 0.f;
    for (int s = tmax - 1; s >= 0; --s) {
        const bf16* kr = base + (size_t)s * NIN + IN_SBK + 64 * h; const bf16* vr = base + (size_t)s * NIN + IN_SBV + 64 * h;
        float z = 0.f;
#pragma unroll
        for (int d = 0; d < 64; ++d) z += q[d] * bf2f(kr[d]);
        if (s < t) {
            const float l1p = log1pf(__expf(-fabsf(z)));
            const float sp = fmaxf(z, 0.f) + l1p, ls = fminf(z, 0.f) - l1p;
            const float w = __expf(ls + after); after -= sp;
#pragma unroll
            for (int d = 0; d < 64; ++d) o[d] += w * bf2f(vr[d]);
        }
    }
    bf16* orow = HM + ((size_t)b * SEQ + t) * D + 64 * h;
#pragma unroll
    for (int d = 0; d < 64; ++d) orow[d] = (bf16)f2bf(o[d]);
}
__global__ void __launch_bounds__(256) k_mla_attn(const bf16* QM, const bf16* KV, const bf16* KR, bf16* HM) {
    const int b = blockIdx.z, h = blockIdx.y, t = blockIdx.x * 256 + threadIdx.x;
    const size_t r0 = (size_t)b * SEQ;
    float q[96], o[64];
    { const bf16* qr = QM + (r0 + t) * NQ; const float sc = 0.10206207261596575f;
#pragma unroll
      for (int d = 0; d < 64; ++d) { q[d] = bf2f(qr[64 * h + d]) * sc; o[d] = 0.f; }
#pragma unroll
      for (int d = 0; d < 16; ++d) { q[64 + d] = bf2f(qr[512 + 16 * h + d]) * sc; q[80 + d] = bf2f(qr[640 + 16 * h + d]) * sc; } }
    const int tmax = __builtin_amdgcn_readfirstlane(blockIdx.x * 256 + (threadIdx.x | 63));
    float m = -1e30f, l = 0.f;
    for (int s = 0; s <= tmax; ++s) {
        const bf16* kn = KV + (r0 + s) * NKV + 64 * h; const bf16* vr = KV + (r0 + s) * NKV + 512 + 64 * h; const bf16* kr = KR + (r0 + s) * 32;
        float z = 0.f;
#pragma unroll
        for (int d = 0; d < 64; ++d) z += q[d] * bf2f(kn[d]);
#pragma unroll
        for (int d = 0; d < 32; ++d) z += q[64 + d] * bf2f(kr[d]);
        if (s <= t) {
            const float mn = fmaxf(m, z), al = __expf(m - mn), pw = __expf(z - mn);
            l = l * al + pw; m = mn;
#pragma unroll
            for (int d = 0; d < 64; ++d) o[d] = o[d] * al + pw * bf2f(vr[d]);
        }
    }
    const float il = 1.f / l;
    bf16* orow = HM + (r0 + t) * D + 256 + 64 * h;
#pragma unroll
    for (int d = 0; d < 64; ++d) orow[d] = (bf16)f2bf(o[d] * il);
}

template <int MODE> static void gemm(hipStream_t st, const bf16* A, int lda, const bf16* Bt, int ldb, int N, int K, void* C, int ldc, const float* aux, float auxdim) {
    GArgs g{A, lda, Bt, ldb, K, C, ldc, aux, auxdim};
    dim3 grid(MODE == 1 ? (N / 256) * 4 : N / 64, T / 64);
    hipLaunchKernelGGL(k_gemm<MODE>, grid, dim3(256), 0, st, g);
}

extern "C" void kernel_launch(void* const* d_in, const int* in_sizes, int n_in, void* d_out, int out_size, void* d_ws, size_t ws_size, hipStream_t stream) {
    if (n_in != 26 || out_size != T * D || ws_size < WS_END) { fprintf(stderr, "kernel_launch: unexpected shapes n_in %d out %d ws %zu\n", n_in, out_size, ws_size); return; }
    Ptrs P{};
    P.x = (const float*)d_in[0]; P.p = (const float*)d_in[1]; P.pos = (const int*)d_in[2];
    const float** f = &P.g_ffn1_pre; for (int i = 0; i < 23; ++i) f[i] = (const float*)d_in[3 + i];
    P.out = (float*)d_out; P.ws = (unsigned char*)d_ws;
    unsigned char* ws = P.ws;
    bf16* WB = (bf16*)(ws + WS_W); bf16* HM = (bf16*)(ws + WS_HM); bf16* KR = (bf16*)(ws + WS_KR); bf16* IN = (bf16*)(ws + WS_IN); bf16* QM = (bf16*)(ws + WS_QM);
    bf16* KV = (bf16*)(ws + WS_KV); bf16* HID = (bf16*)(ws + WS_HID); bf16* Y = (bf16*)(ws + WS_Y); bf16* P16 = (bf16*)(ws + WS_P16); float* PP = (float*)(ws + WS_PP);
    float* SSQ = (float*)(ws + WS_SSQ); float* SSKV = (float*)(ws + WS_SSKV); float* RT = (float*)(ws + WS_ROPE); float* X = P.out;
    hipLaunchKernelGGL(k_prep, dim3(1024), dim3(256), 0, stream, P);
    for (int l = 0; l < DEPTH; ++l) {
        bf16* wl = WB + (size_t)l * W_LAYER;
        gemm<1>(stream, HM, D, wl + WO_GU1, D, NGU, D, HID, FF, nullptr, 0.f);
        gemm<0>(stream, HID, FF, wl + WO_D1, FF, D, FF, Y, D, nullptr, 0.f);
        hipLaunchKernelGGL(k_norm_step, dim3(1024), dim3(256), 0, stream, Y, X, HM, 0.5f, P.g_ffn1_post + l * D, P.g_mix_pre + l * D);
        gemm<0>(stream, HM, D, wl + WO_IN, D, NIN, D, IN, NIN, nullptr, 0.f);
        hipLaunchKernelGGL(k_rowss, dim3(1024), dim3(256), 0, stream, IN, SSQ + l * T, SSKV + l * T);
        hipLaunchKernelGGL(k_mix_elem, dim3(1024), dim3(256), 0, stream, IN, RT, P.w_conv + l * 3 * 256, KR, HM);
        gemm<2>(stream, IN + IN_CQ, NIN, wl + WO_UQ, QRANK, NQ, QRANK, QM, NQ, SSQ + l * T, (float)QRANK);
        hipLaunchKernelGGL(k_rope_q, dim3(1024), dim3(256), 0, stream, QM, RT);
        gemm<2>(stream, IN + IN_CKV, NIN, wl + WO_UKV, KVRANK, NKV, KVRANK, KV, NKV, SSKV + l * T, (float)KVRANK);
        hipLaunchKernelGGL(k_sb_attn, dim3(SEQ / 256, 4, BATCH), dim3(256), 0, stream, IN, HM);
        hipLaunchKernelGGL(k_mla_attn, dim3(SEQ / 256, 8, BATCH), dim3(256), 0, stream, QM, KV, KR, HM);
        gemm<0>(stream, HM, D, wl + WO_OUT, D, D, D, Y, D, nullptr, 0.f);
        hipLaunchKernelGGL(k_norm_step, dim3(1024), dim3(256), 0, stream, Y, X, HM, 1.0f, P.g_mix_post + l * D, P.g_ffn2_pre + l * D);
        gemm<1>(stream, HM, D, wl + WO_GU2, D, NGU, D, HID, FF, nullptr, 0.f);
        gemm<0>(stream, HID, FF, wl + WO_D2, FF, D, FF, Y, D, nullptr, 0.f);
        hipLaunchKernelGGL(k_norm_step, dim3(1024), dim3(256), 0, stream, Y, X, HM, 0.5f, P.g_ffn2_post + l * D, P.g_ple_pre + l * D);
        hipLaunchKernelGGL(k_cvt_p, dim3(1024), dim3(256), 0, stream, P.p + (size_t)l * T * PLE, P16);
        gemm<3>(stream, P16, PLE, wl + WO_PP, PLE, D, PLE, PP, D, nullptr, 0.f);
        gemm<4>(stream, HM, D, wl + WO_PG, D, D, D, Y, D, PP, 0.f);
        hipLaunchKernelGGL(k_norm_step, dim3(1024), dim3(256), 0, stream, Y, X, HM, 1.0f, P.g_ple_post + l * D, (const float*)(l + 1 < DEPTH ? P.g_ffn1_pre + (l + 1) * D : nullptr));
    }
}
```

```cpp
#include <hip/hip_runtime.h>
#include <cstdio>
#include <cstdint>
#include <cmath>

typedef unsigned short bf16;
typedef short bf16x8 __attribute__((ext_vector_type(8)));
typedef float f32x4 __attribute__((ext_vector_type(4)));
typedef unsigned u32x4 __attribute__((ext_vector_type(4)));
typedef unsigned u32x2 __attribute__((ext_vector_type(2)));

constexpr int BATCH = 8, SEQ = 2048, T = BATCH * SEQ, D = 1024, FF = 2816, DEPTH = 2;
constexpr int NGU = 2 * FF;
constexpr int NIN = 2304;
constexpr int IN_SBQ = 0, IN_SBK = 256, IN_SBV = 512, IN_CQ = 768, IN_KR = 1152, IN_CKV = 1280, IN_CVB = 1536, IN_CVC = 1792, IN_CVH = 2048;
constexpr int QRANK = 384, KVRANK = 256, NQ = 768, NKV = 1024, PLE = 256;
constexpr float EPS = 1e-6f;

constexpr size_t MiB = 1u << 20;
constexpr size_t WS_CTL = 0;
constexpr size_t WS_SSQ = 1 * MiB;
constexpr size_t WS_SSKV = WS_SSQ + 2 * T * 4;
constexpr size_t WS_ROPE = 2 * MiB;
constexpr size_t WS_W = 4 * MiB;
constexpr size_t WO_GU1 = 0, WO_D1 = WO_GU1 + (size_t)NGU * D, WO_GU2 = WO_D1 + (size_t)D * FF, WO_D2 = WO_GU2 + (size_t)NGU * D,
                 WO_IN = WO_D2 + (size_t)D * FF, WO_UQ = WO_IN + (size_t)NIN * D, WO_UKV = WO_UQ + (size_t)NQ * QRANK,
                 WO_OUT = WO_UKV + (size_t)NKV * KVRANK, WO_PG = WO_OUT + (size_t)D * D, WO_PP = WO_PG + (size_t)D * D,
                 W_LAYER = WO_PP + (size_t)D * PLE;
constexpr size_t WS_HM = 92 * MiB;
constexpr size_t WS_KR = 124 * MiB;
constexpr size_t WS_REG = 125 * MiB;
constexpr size_t WS_IN = WS_REG, WS_QM = WS_REG + 72 * MiB, WS_KV = WS_REG + 96 * MiB;
constexpr size_t WS_HID = WS_REG, WS_Y = WS_REG + 88 * MiB, WS_P16 = WS_REG + 120 * MiB;
constexpr size_t WS_PP = WS_REG;
constexpr size_t WS_END = WS_REG + 128 * MiB;
static_assert(WS_W + 2 * W_LAYER * 2 <= WS_HM, "weights fit");

__device__ __forceinline__ unsigned f2bf(float f) { unsigned u = __float_as_uint(f); return (u + 0x7fffu + ((u >> 16) & 1u)) >> 16; }
__device__ __forceinline__ unsigned pk2(float lo, float hi) { return f2bf(lo) | (f2bf(hi) << 16); }
__device__ __forceinline__ float bf2f(unsigned short b) { return __uint_as_float((unsigned)b << 16); }
__device__ __forceinline__ float wave_sum(float v) {
#pragma unroll
    for (int o = 1; o < 64; o <<= 1) v += __shfl_xor(v, o);
    return v;
}

enum { MAP_ID = 0, MAP_GATE, MAP_UP, MAP_IN, MAP_UQ, MAP_UKV };
__device__ __forceinline__ int dmap(int kind, int c) {
    switch (kind) {
        case MAP_GATE: return 256 * (c >> 7) + (c & 127);
        case MAP_UP:   return 256 * (c >> 7) + 128 + (c & 127);
        case MAP_IN:   return c < 1152 ? c : (c < 1408 ? IN_CKV + (c - 1152) : (c < 1440 ? IN_KR + (c - 1408) : IN_CVB + (c - 1440)));
        case MAP_UQ:   { const int h = c / 96, d = c % 96; return d < 64 ? 64 * h + d : (d < 80 ? 512 + 16 * h + (d - 64) : 640 + 16 * h + (d - 80)); }
        case MAP_UKV:  { const int h = c >> 7, d = c & 127; return d < 64 ? 64 * h + d : 512 + 64 * h + (d - 64); }
        default: return c;
    }
}
__device__ __forceinline__ void prep_item(const float* W, int K, int Nsrc, bf16* WT, int kind, const float* gain, float* scr, int item, int lane) {
    const int nblk = Nsrc / 32, kb = item / nblk, nb = item % nblk, k0 = 64 * kb, n0 = 32 * nb;
#pragma unroll 8
    for (int i = 0; i < 32; ++i) { const int kk = 2 * i + (lane >> 5); float v = W[(size_t)(k0 + kk) * Nsrc + n0 + (lane & 31)]; if (gain) v *= gain[k0 + kk]; scr[kk * 33 + (lane & 31)] = v; }
    __builtin_amdgcn_s_waitcnt(0xc07f); __builtin_amdgcn_wave_barrier();
    const int c = lane & 7;
#pragma unroll
    for (int j = 0; j < 4; ++j) { const int n = (lane >> 3) + 8 * j; const float* s = scr + (8 * c) * 33 + n;
        u32x4 o; o.x = pk2(s[0 * 33], s[1 * 33]); o.y = pk2(s[2 * 33], s[3 * 33]); o.z = pk2(s[4 * 33], s[5 * 33]); o.w = pk2(s[6 * 33], s[7 * 33]);
        *(u32x4*)(WT + (size_t)dmap(kind, n0 + n) * K + k0 + 8 * c) = o; }
    __builtin_amdgcn_s_waitcnt(0xc07f); __builtin_amdgcn_wave_barrier();
}

struct Ptrs {
    const float* x; const float* p; const int* pos;
    const float *g_ffn1_pre, *w1_gate, *w1_up, *w1_down, *g_ffn1_post, *g_mix_pre, *w_in, *g_mla_q, *w_mla_uq, *g_mla_kv, *w_mla_ukv, *w_conv, *w_out,
                *g_mix_post, *g_ffn2_pre, *w2_gate, *w2_up, *w2_down, *g_ffn2_post, *g_ple_pre, *w_ple_gate, *w_ple_proj, *g_ple_post;
    float* out; unsigned char* ws;
};

__device__ __forceinline__ void norm_row_first(const float* xrow, float* Xrow, bf16* hrow, const float* g, int lane) {
    f32x4 v[4]; float s = 0.f;
#pragma unroll
    for (int j = 0; j < 4; ++j) { v[j] = *(const f32x4*)(xrow + 4 * lane + 256 * j); s += (v[j].x * v[j].x + v[j].y * v[j].y) + (v[j].z * v[j].z + v[j].w * v[j].w); }
    const float r = 1.0f / sqrtf(wave_sum(s) * (1.f / D) + EPS);
#pragma unroll
    for (int j = 0; j < 4; ++j) { *(f32x4*)(Xrow + 4 * lane + 256 * j) = v[j]; const f32x4 gg = *(const f32x4*)(g + 4 * lane + 256 * j);
        u32x2 o; o.x = pk2(v[j].x * r * gg.x, v[j].y * r * gg.y); o.y = pk2(v[j].z * r * gg.z, v[j].w * r * gg.w); *(u32x2*)(hrow + 4 * lane + 256 * j) = o; }
}
__device__ __forceinline__ void norm_row_step(const bf16* yrow, float* Xrow, bf16* hrow, float w, const float* g_post, const float* g_next, int lane) {
    f32x4 y[4], x[4]; float s = 0.f;
#pragma unroll
    for (int j = 0; j < 4; ++j) { const u32x2 u = *(const u32x2*)(yrow + 4 * lane + 256 * j);
        y[j].x = __uint_as_float(u.x << 16); y[j].y = __uint_as_float(u.x & 0xffff0000u); y[j].z = __uint_as_float(u.y << 16); y[j].w = __uint_as_float(u.y & 0xffff0000u);
        s += (y[j].x * y[j].x + y[j].y * y[j].y) + (y[j].z * y[j].z + y[j].w * y[j].w); }
    const float r = w / sqrtf(wave_sum(s) * (1.f / D) + EPS); float s2 = 0.f;
#pragma unroll
    for (int j = 0; j < 4; ++j) { const f32x4 gg = *(const f32x4*)(g_post + 4 * lane + 256 * j); x[j] = *(const f32x4*)(Xrow + 4 * lane + 256 * j);
        x[j].x += y[j].x * r * gg.x; x[j].y += y[j].y * r * gg.y; x[j].z += y[j].z * r * gg.z; x[j].w += y[j].w * r * gg.w;
        *(f32x4*)(Xrow + 4 * lane + 256 * j) = x[j]; s2 += (x[j].x * x[j].x + x[j].y * x[j].y) + (x[j].z * x[j].z + x[j].w * x[j].w); }
    if (g_next) { const float r2 = 1.0f / sqrtf(wave_sum(s2) * (1.f / D) + EPS);
#pragma unroll
        for (int j = 0; j < 4; ++j) { const f32x4 gg = *(const f32x4*)(g_next + 4 * lane + 256 * j);
            u32x2 o; o.x = pk2(x[j].x * r2 * gg.x, x[j].y * r2 * gg.y); o.y = pk2(x[j].z * r2 * gg.z, x[j].w * r2 * gg.w); *(u32x2*)(hrow + 4 * lane + 256 * j) = o; } }
}

namespace pg8 {
#define PG8_LAS __attribute__((address_space(3)))
typedef unsigned short bf16_t;
typedef short bf16x8 __attribute__((ext_vector_type(8)));
typedef float f32x4 __attribute__((ext_vector_type(4)));
typedef unsigned u32x4 __attribute__((ext_vector_type(4)));
constexpr int BM = 256, BK = 64, HALF = 128, HTB = HALF * BK * 2  , STAGE_BYTES = 8 * HTB, NXCD = 8, WGM = 8;

__host__ __device__ __forceinline__ int lds_byte(int r, int c) { const int st = (r >> 4) * 2 + (c >> 5), rr = r & 15, cc = c & 31, ob = rr * 64 + cc * 2; return st * 1024 + (ob ^ (((ob >> 9) & 1) << 5)); }
__host__ __device__ __forceinline__ void stage_rc(int b, int& R, int& C) { const int st = b / 1024, sb = b % 1024, swz = sb ^ (((sb >> 9) & 1) << 5); R = (st >> 1) * 16 + swz / 64; C = (st & 1) * 32 + (swz % 64) / 2; }
__host__ __device__ __forceinline__ int perm32(int rho) { const int n = rho >> 4, i = rho & 15; return 8 * (i >> 2) + 4 * n + (i & 3); }

struct Unit { int pm, pn; };
struct Gemm { const bf16_t* A; const bf16_t* Bt; int M, N, K, lda, ldb, pad; };

struct StaticOrder {
    int nM, nN, nwg, G, c;
    __host__ __device__ void init(int M, int N, int G_, int c_) { nM = M / BM; nN = N / BM; nwg = nM * nN; G = G_; c = c_; }
    __host__ __device__ bool next(int i, Unit& u) const {
        const long L = (long)i * G + c; if (L >= nwg) return false;
        int wgid = (int)L; { const int q = nwg / NXCD, r = nwg % NXCD, xcd = wgid % NXCD, off = wgid / NXCD; wgid = (xcd < r ? xcd * (q + 1) : r * (q + 1) + (xcd - r) * q) + off; }
        const int nig = WGM * nN, gid = wgid / nig, fm = gid * WGM, gsz = (nM - fm) < WGM ? (nM - fm) : WGM;
        u.pm = fm + ((wgid % nig) % gsz); u.pn = (wgid % nig) / gsz; return true;
    }
    __device__ __forceinline__ void a_ready(const Unit&) const {}
    __device__ __forceinline__ void done(const Unit&) const {}
};


template <class Epi, class Sched, bool ALIGN_EPI = false, bool SP2 = false>
__device__ __forceinline__ void gemm_phase(PG8_LAS unsigned char* lds, const Gemm g, const Sched& S, const Epi& E) {
    const int tid = threadIdx.x, wid = __builtin_amdgcn_readfirstlane(tid >> 6), lane = tid & 63, wr = wid >> 2, wc = wid & 3, fr = lane & 15, fq = lane >> 4;
    const int K = g.K, nt = K / BK;
    unsigned voffA[2], voffB[2];
#pragma unroll
    for (int i = 0; i < 2; ++i) { int R, C; stage_rc(tid * 16 + i * 8192, R, C); const int Rb = Epi::PERM ? ((R & ~31) + perm32(R & 31)) : R;
        voffA[i] = (unsigned)(R * g.lda + C) * 2u; voffB[i] = (unsigned)(Rb * g.ldb + C) * 2u; }
    const size_t kstep = (size_t)(BK * 2);
    const size_t hstepA = (size_t)HALF * g.lda * 2, hstepB = (size_t)HALF * g.ldb * 2;
    const size_t tstepA = 2 * hstepA, tstepB = 2 * hstepB;
    const unsigned ldsw = (unsigned)wid * 1024u;
    const int aoff = lds_byte(wr * 64 + fr, fq * 8), boff = lds_byte(wc * 32 + fr, fq * 8);
#define PG8_SA(b, h) (((b) * 2 + (h)) * HTB)
#define PG8_SB(b, h) ((4 + (b) * 2 + (h)) * HTB)
#define PG8_STAGE(bufoff, gbase, voff) do { _Pragma("unroll") for (int _i = 0; _i < 2; ++_i) \
        __builtin_amdgcn_global_load_lds((const unsigned*)((const char*)(gbase) + (voff)[_i]), (PG8_LAS unsigned*)(lds + (bufoff) + ldsw + _i * 8192), 16, 0, 0); } while (0)
#define PG8_LDA(dst, b, h) do { _Pragma("unroll") for (int m = 0; m < 4; ++m) _Pragma("unroll") for (int k = 0; k < 2; ++k) dst[m][k] = *(const PG8_LAS bf16x8*)(lds + PG8_SA(b, h) + aoff + m * 2048 + k * 1024); } while (0)
#define PG8_LDB(dst, b, h) do { _Pragma("unroll") for (int n = 0; n < 2; ++n) _Pragma("unroll") for (int k = 0; k < 2; ++k) dst[n][k] = *(const PG8_LAS bf16x8*)(lds + PG8_SB(b, h) + boff + n * 2048 + k * 1024); } while (0)
#define PG8_MMA(ai, bj, At, Bt) do { __builtin_amdgcn_s_setprio(1); _Pragma("unroll") for (int m = 0; m < 4; ++m) _Pragma("unroll") for (int n = 0; n < 2; ++n) _Pragma("unroll") for (int k = 0; k < 2; ++k) \
        acc[ai][bj][m][n] = __builtin_amdgcn_mfma_f32_16x16x32_bf16(Bt[n][k], At[m][k], acc[ai][bj][m][n], 0, 0, 0); __builtin_amdgcn_s_setprio(0); } while (0)
#define PG8_WAIT_V(n) asm volatile("s_waitcnt vmcnt(" #n ")" ::: "memory")
#define PG8_WAIT_L(n) asm volatile("s_waitcnt lgkmcnt(" #n ")" ::: "memory")
#define PG8_BAR __builtin_amdgcn_s_barrier()
#define PG8_SCHED __builtin_amdgcn_sched_barrier(0)
    Unit cur, nxt; int ui = 0;
    if (!S.next(0, cur)) return;
    f32x4 acc[2][2][4][2];
#pragma unroll
    for (int a = 0; a < 2; ++a)
#pragma unroll
        for (int b = 0; b < 2; ++b)
#pragma unroll
            for (int m = 0; m < 4; ++m)
#pragma unroll
                for (int n = 0; n < 2; ++n) acc[a][b][m][n] = (f32x4){0.f, 0.f, 0.f, 0.f};
    bf16x8 At[4][2], B0[2][2], B1[2][2];
    const char* cA = (const char*)g.A + (size_t)cur.pm * tstepA; const char* cB = (const char*)g.Bt + (size_t)cur.pn * tstepB;
    S.a_ready(cur);
    if constexpr (SP2) {
        PG8_STAGE(PG8_SB(0, 0), cB, voffB); PG8_STAGE(PG8_SB(0, 1), cB + hstepB, voffB); PG8_STAGE(PG8_SA(0, 0), cA, voffA); PG8_STAGE(PG8_SA(0, 1), cA + hstepA, voffA);
        if (wr == 1) PG8_BAR;
        PG8_WAIT_V(2); PG8_BAR;
        PG8_STAGE(PG8_SB(1, 0), cB + kstep, voffB); PG8_STAGE(PG8_SA(1, 0), cA + kstep, voffA); PG8_STAGE(PG8_SB(1, 1), cB + hstepB + kstep, voffB);
        PG8_WAIT_V(6); PG8_BAR;
    } else {
        PG8_STAGE(PG8_SB(0, 0), cB, voffB); PG8_STAGE(PG8_SA(0, 0), cA, voffA); PG8_STAGE(PG8_SB(0, 1), cB + hstepB, voffB); PG8_STAGE(PG8_SA(0, 1), cA + hstepA, voffA);
        if (wr == 1) PG8_BAR;
        PG8_WAIT_V(4); PG8_BAR;
        PG8_STAGE(PG8_SB(1, 0), cB + kstep, voffB); PG8_STAGE(PG8_SA(1, 0), cA + kstep, voffA); PG8_STAGE(PG8_SB(1, 1), cB + hstepB + kstep, voffB);
        PG8_WAIT_V(6); PG8_BAR;
    }
    for (;;) {
        const bool has_next = S.next(ui + 1, nxt);
        const char* nA = has_next ? (const char*)g.A + (size_t)nxt.pm * tstepA : cA; const char* nB = has_next ? (const char*)g.Bt + (size_t)nxt.pn * tstepB : cB;
        for (int t = 0; t < nt; t += 2) {
            const bool last = (t == nt - 2);
            const char* a1 = cA + (size_t)(t + 1) * kstep;
            const char* a2 = last ? nA : cA + (size_t)(t + 2) * kstep; const char* b2 = last ? nB : cB + (size_t)(t + 2) * kstep;
            const char* a3 = a2 + kstep; const char* b3 = b2 + kstep;
            if (last && has_next) S.a_ready(nxt);
            if constexpr (SP2) {
            PG8_LDB(B0, 0, 0); PG8_LDB(B1, 0, 1); PG8_SCHED; PG8_LDA(At, 0, 0); PG8_STAGE(PG8_SA(1, 1), a1 + hstepA, voffA);
            PG8_WAIT_V(8); PG8_WAIT_L(0); PG8_BAR; PG8_MMA(0, 0, At, B0); PG8_MMA(0, 1, At, B1); PG8_BAR; PG8_SCHED;
            PG8_LDA(At, 0, 1); PG8_STAGE(PG8_SB(0, 0), b2, voffB); PG8_STAGE(PG8_SB(0, 1), b2 + hstepB, voffB); PG8_STAGE(PG8_SA(0, 0), a2, voffA);
            PG8_WAIT_V(8); PG8_WAIT_L(0); PG8_BAR; PG8_MMA(1, 0, At, B0); PG8_MMA(1, 1, At, B1); PG8_BAR; PG8_SCHED;
            PG8_LDB(B0, 1, 0); PG8_LDB(B1, 1, 1); PG8_SCHED; PG8_LDA(At, 1, 0); PG8_STAGE(PG8_SA(0, 1), a2 + hstepA, voffA);
            PG8_WAIT_V(8); PG8_WAIT_L(0); PG8_BAR; PG8_MMA(0, 0, At, B0); PG8_MMA(0, 1, At, B1); PG8_BAR; PG8_SCHED;
            PG8_LDA(At, 1, 1); PG8_STAGE(PG8_SB(1, 0), b3, voffB); PG8_STAGE(PG8_SB(1, 1), b3 + hstepB, voffB); PG8_STAGE(PG8_SA(1, 0), a3, voffA);
            PG8_WAIT_V(8); PG8_WAIT_L(0); PG8_BAR; PG8_MMA(1, 0, At, B0); PG8_MMA(1, 1, At, B1); PG8_BAR; PG8_SCHED;
            } else {
            PG8_LDB(B0, 0, 0); PG8_SCHED; PG8_LDA(At, 0, 0); PG8_STAGE(PG8_SA(1, 1), a1 + hstepA, voffA);
            PG8_WAIT_L(8); PG8_BAR; PG8_WAIT_L(0); PG8_MMA(0, 0, At, B0); PG8_BAR; PG8_SCHED;
            PG8_LDB(B1, 0, 1); PG8_STAGE(PG8_SB(0, 0), b2, voffB);
            PG8_BAR; PG8_WAIT_L(0); PG8_MMA(0, 1, At, B1); PG8_BAR;
            PG8_LDA(At, 0, 1); PG8_STAGE(PG8_SA(0, 0), a2, voffA);
            PG8_BAR; PG8_WAIT_L(0); PG8_MMA(1, 0, At, B0); PG8_BAR; PG8_SCHED;
            PG8_STAGE(PG8_SB(0, 1), b2 + hstepB, voffB);
            PG8_WAIT_V(6); PG8_BAR; PG8_MMA(1, 1, At, B1); PG8_BAR;
            PG8_LDB(B0, 1, 0); PG8_SCHED; PG8_LDA(At, 1, 0); PG8_STAGE(PG8_SA(0, 1), a2 + hstepA, voffA);
            PG8_WAIT_L(8); PG8_BAR; PG8_WAIT_L(0); PG8_MMA(0, 0, At, B0); PG8_BAR; PG8_SCHED;
            PG8_LDB(B1, 1, 1); PG8_STAGE(PG8_SB(1, 0), b3, voffB);
            PG8_BAR; PG8_WAIT_L(0); PG8_MMA(0, 1, At, B1); PG8_BAR;
            PG8_LDA(At, 1, 1); PG8_STAGE(PG8_SA(1, 0), a3, voffA);
            PG8_BAR; PG8_WAIT_L(0); PG8_MMA(1, 0, At, B0); PG8_BAR; PG8_SCHED;
            PG8_STAGE(PG8_SB(1, 1), b3 + hstepB, voffB);
            PG8_WAIT_V(6); PG8_BAR; PG8_MMA(1, 1, At, B1); PG8_BAR;
            }
        }
        if constexpr (ALIGN_EPI) { if (wr == 0) PG8_BAR; }
        if constexpr (!Epi::AFTER_DRAIN) { E(acc, cur, wr, wc, fr, fq); S.done(cur); }
        if (!has_next) break;
#pragma unroll
        for (int a = 0; a < 2; ++a)
#pragma unroll
            for (int b = 0; b < 2; ++b)
#pragma unroll
                for (int m = 0; m < 4; ++m)
#pragma unroll
                    for (int n = 0; n < 2; ++n) acc[a][b][m][n] = (f32x4){0.f, 0.f, 0.f, 0.f};
        cur = nxt; cA = nA; cB = nB; ++ui;
        if constexpr (ALIGN_EPI) { if (wr == 1) PG8_BAR; }
    }
    PG8_WAIT_V(0);
    if constexpr (!ALIGN_EPI) { if (wr == 0) PG8_BAR; }
    PG8_BAR;
    if constexpr (Epi::AFTER_DRAIN) { E.fused(acc, cur, wr, wc, fr, fq, lds, wid, lane); S.done(cur); }
#undef PG8_SA
#undef PG8_SB
#undef PG8_STAGE
#undef PG8_LDA
#undef PG8_LDB
#undef PG8_MMA
#undef PG8_WAIT_V
#undef PG8_WAIT_L
#undef PG8_BAR
#undef PG8_SCHED
}
}

namespace pg8 {
__device__ __forceinline__ unsigned cvt_pk_bf16(float lo, float hi) { unsigned r; asm volatile("v_cvt_pk_bf16_f32 %0, %1, %2" : "=v"(r) : "v"(lo), "v"(hi)); return r; }
__device__ __forceinline__ float silu_f(float x) { return x * __builtin_amdgcn_rcpf(1.f + __builtin_amdgcn_exp2f(-1.4426950408889634f * x)); }
__device__ __forceinline__ float sigmoid_f(float x) { return __builtin_amdgcn_rcpf(1.f + __builtin_amdgcn_exp2f(-1.4426950408889634f * x)); }
__device__ __forceinline__ u32x4 pack8(const f32x4& a, const f32x4& b) { u32x4 w; w.x = cvt_pk_bf16(a[0], a[1]); w.y = cvt_pk_bf16(a[2], a[3]); w.z = cvt_pk_bf16(b[0], b[1]); w.w = cvt_pk_bf16(b[2], b[3]); return w; }
struct EpiGU {
    static constexpr bool PERM = true, AFTER_DRAIN = false;
    bf16_t* H; int ldh, pad;
    __device__ __forceinline__ void operator()(const f32x4 (&acc)[2][2][4][2], const Unit& u, int wr, int wc, int fr, int fq) const {
        const int row0 = u.pm * BM + wr * 64 + fr, col0 = u.pn * HALF + wc * 32 + 8 * fq;
#pragma unroll
        for (int ai = 0; ai < 2; ++ai)
#pragma unroll
            for (int m = 0; m < 4; ++m) { bf16_t* rowp = H + (size_t)(row0 + ai * HALF + m * 16) * ldh + col0;
                f32x4 h0, h1;
#pragma unroll
                for (int j = 0; j < 4; ++j) { h0[j] = silu_f(acc[ai][0][m][0][j]) * acc[ai][1][m][0][j]; h1[j] = silu_f(acc[ai][0][m][1][j]) * acc[ai][1][m][1][j]; }
                *(u32x4*)rowp = pack8(h0, h1); }
    }
};
template <int KIND> struct EpiStore {
    static constexpr bool PERM = true, AFTER_DRAIN = false;
    bf16_t* O; float* ssq; float* sskv; const float* ss; const float* rt; int ldc; float ssdim;
    __device__ __forceinline__ void operator()(const f32x4 (&acc)[2][2][4][2], const Unit& u, int wr, int wc, int fr, int fq) const {
        const int row0 = u.pm * BM + wr * 64 + fr, col0 = u.pn * BM + wc * 32 + 8 * fq;
#pragma unroll
        for (int ai = 0; ai < 2; ++ai)
#pragma unroll
            for (int m = 0; m < 4; ++m) { const int row = row0 + ai * HALF + m * 16; bf16_t* rowp = O + (size_t)row * ldc + col0;
                f32x4 v[2][2];
#pragma unroll
                for (int bj = 0; bj < 2; ++bj) { v[bj][0] = acc[ai][bj][m][0]; v[bj][1] = acc[ai][bj][m][1]; }
                if (KIND == 2 || KIND == 3) { const float sc = 1.0f / sqrtf(ss[row] / ssdim + 1e-6f);
#pragma unroll
                    for (int bj = 0; bj < 2; ++bj) { v[bj][0] = v[bj][0] * sc; v[bj][1] = v[bj][1] * sc; } }
                if (KIND == 2) { if (u.pn == 2) {
#pragma unroll
                    for (int n = 0; n < 2; ++n) { const f32x4 cs = *(const f32x4*)(rt + (size_t)row * 32 + 8 * (fq & 1) + 4 * n), sn = *(const f32x4*)(rt + (size_t)row * 32 + 16 + 8 * (fq & 1) + 4 * n);
                        const f32x4 x1 = v[0][n], x2 = v[1][n]; v[0][n] = x1 * cs - x2 * sn; v[1][n] = x2 * cs + x1 * sn; } } }
                if (KIND == 1) { if (u.pn >= 3 && u.pn <= 5) { float part = 0.f;
#pragma unroll
                    for (int bj = 0; bj < 2; ++bj) if (bj == 0 || u.pn != 4)
#pragma unroll
                        for (int n = 0; n < 2; ++n) { const f32x4 x = v[bj][n]; part += (x[0] * x[0] + x[1] * x[1]) + (x[2] * x[2] + x[3] * x[3]); }
                    part += __shfl_xor(part, 16); part += __shfl_xor(part, 32);
                    if (fq == 0) atomicAdd((u.pn == 5 ? sskv : ssq) + row, part); } }
#pragma unroll
                for (int bj = 0; bj < 2; ++bj) *(u32x4*)(rowp + bj * HALF) = pack8(v[bj][0], v[bj][1]); }
    }
};
template <bool FIRST> struct EpiPle {
    static constexpr bool PERM = true, AFTER_DRAIN = false;
    float* PP; bf16_t* E; int ldc, pad;
    __device__ __forceinline__ void operator()(const f32x4 (&acc)[2][2][4][2], const Unit& u, int wr, int wc, int fr, int fq) const {
        const int row0 = u.pm * BM + wr * 64 + fr, col0 = u.pn * BM + wc * 32 + 8 * fq;
#pragma unroll
        for (int ai = 0; ai < 2; ++ai)
#pragma unroll
            for (int m = 0; m < 4; ++m) { const size_t off = (size_t)(row0 + ai * HALF + m * 16) * ldc + col0;
#pragma unroll
                for (int bj = 0; bj < 2; ++bj) {
                    if (FIRST) { *(f32x4*)(PP + off + bj * HALF) = acc[ai][bj][m][0]; *(f32x4*)(PP + off + bj * HALF + 4) = acc[ai][bj][m][1]; }
                    else { const f32x4 p0 = *(const f32x4*)(PP + off + bj * HALF), p1 = *(const f32x4*)(PP + off + bj * HALF + 4); f32x4 e0, e1;
#pragma unroll
                        for (int j = 0; j < 4; ++j) { e0[j] = sigmoid_f(acc[ai][bj][m][0][j]) * p0[j]; e1[j] = sigmoid_f(acc[ai][bj][m][1][j]) * p1[j]; }
                        *(u32x4*)(E + off + bj * HALF) = pack8(e0, e1); } } }
    }
};
}
constexpr int GEMM_LDS = 131072;
template <class Epi> __global__ void __launch_bounds__(512, 2) k_pg8(pg8::Gemm g, Epi e) {
    extern __shared__ __attribute__((aligned(16))) unsigned char lds[];
    pg8::StaticOrder S; S.init(g.M, g.N, (int)gridDim.x, (int)blockIdx.x);
    pg8::gemm_phase<Epi, pg8::StaticOrder, true, true>((PG8_LAS unsigned char*)lds, g, S, e);
}
template <class Epi> static void pgemm(hipStream_t st, const bf16* A, int lda, const bf16* Bt, int ldb, int N, int K, const Epi& e) {
    static bool once = false;
    if (!once) { once = true; if (hipFuncSetAttribute((const void*)k_pg8<Epi>, hipFuncAttributeMaxDynamicSharedMemorySize, GEMM_LDS) != hipSuccess) fprintf(stderr, "hipFuncSetAttribute failed\n"); }
    pg8::Gemm g{A, Bt, T, N, K, lda, ldb, 0};
    hipLaunchKernelGGL(k_pg8<Epi>, dim3(256), dim3(512), GEMM_LDS, st, g, e);
}


namespace att {
#define ATT_LAS __attribute__((address_space(3)))
typedef float f32x16 __attribute__((ext_vector_type(16)));
typedef short s16x4 __attribute__((ext_vector_type(4)));
typedef float f32x2_t __attribute__((ext_vector_type(2)));
typedef __bf16 bf16x2_t __attribute__((ext_vector_type(2)));
__device__ __forceinline__ unsigned cvtpk(float lo, float hi) { f32x2_t v = {lo, hi}; bf16x2_t b = __builtin_convertvector(v, bf16x2_t); return __builtin_bit_cast(unsigned, b); }
__device__ __forceinline__ int rho(int kp) { const int h = kp >> 4, r = kp & 15; return (r & 3) + 8 * (r >> 2) + 4 * h; }
__device__ __forceinline__ float swap_other(float v) { auto rr = __builtin_amdgcn_permlane32_swap(__float_as_uint(v), __float_as_uint(v), false, false);
    return (threadIdx.x & 32) ? __uint_as_float(rr[0]) : __uint_as_float(rr[1]); }
struct AttnP { const bf16* IN; const bf16* QM; const bf16* KV; const bf16* KR; bf16* HM; };
constexpr int VSTR = 192;
constexpr int ATT_LDS = 2 * 64 * (208 + VSTR) + 64;
constexpr float L2E = 1.4426950408889634f;

template <bool SB> __device__ __forceinline__ void attn_unit(ATT_LAS unsigned char* lds, const AttnP& P, int b, int h, int qb) {
    constexpr int DKS = SB ? 4 : 6, KSTR = SB ? 144 : 208, KBUF = 64 * KSTR, VBUF = 64 * VSTR, BUF = KBUF + VBUF;
    const int tid = threadIdx.x, lane = tid & 63, wid = __builtin_amdgcn_readfirstlane(tid >> 6), r32 = lane & 31, hh = lane >> 5;
    const size_t row0 = (size_t)b * SEQ;
    const int R0 = qb * 256, qrow = R0 + 32 * wid + r32;
    ATT_LAS int* flags = (ATT_LAS int*)(lds + 2 * 64 * (208 + VSTR));
    bf16x8 qf[DKS];
    if (SB) { const bf16* q = P.IN + (row0 + qrow) * NIN + IN_SBQ + 64 * h;
#pragma unroll
        for (int ks = 0; ks < 4; ++ks) qf[ks] = *(const bf16x8*)(q + 16 * ks + 8 * hh); }
    else { const bf16* q = P.QM + (row0 + qrow) * NQ;
#pragma unroll
        for (int ks = 0; ks < 4; ++ks) qf[ks] = *(const bf16x8*)(q + 64 * h + 16 * ks + 8 * hh);
        qf[DKS - 2] = *(const bf16x8*)(q + 512 + 16 * h + 8 * hh); qf[DKS - 1] = *(const bf16x8*)(q + 640 + 16 * h + 8 * hh); }
    const int skey = tid >> 3, sch = tid & 7, srow = 32 * (skey >> 5) + rho(skey & 31);
    const int rkey = (tid >> 2) & 63, rrow = 32 * (rkey >> 5) + rho(rkey & 31);
    const bf16* kg = SB ? P.IN + (row0 + skey) * NIN + IN_SBK + 64 * h + 8 * sch : P.KV + (row0 + skey) * NKV + 64 * h + 8 * sch;
    const bf16* vg = SB ? P.IN + (row0 + skey) * NIN + IN_SBV + 64 * h + 8 * sch : P.KV + (row0 + skey) * NKV + 512 + 64 * h + 8 * sch;
    const bf16* rg = P.KR + (row0 + rkey) * 32 + 8 * (tid & 3);
    const size_t kvpitch = SB ? NIN : NKV;
    const int kdst = srow * KSTR + 16 * sch, vdst = KBUF + srow * VSTR + 16 * sch, rdst = rrow * KSTR + 128 + 16 * (tid & 3);
    const int jhi = 4 * qb + 3, ntiles = jhi + 1, jw = 4 * qb + (wid >> 1);
    const int kfr = r32 * KSTR + 16 * hh;
    const int vfr = KBUF + (4 * hh + ((lane & 15) >> 2)) * VSTR + (16 * ((lane >> 4) & 1) + 4 * (lane & 3)) * 2;
    f32x16 o0 = {}, o1 = {};
    float carry = 0.f;
    float lsum = 0.f;
    if (!SB) carry = -1e30f;
    constexpr float CS = SB ? 0.125f * L2E : 0.10206207261596575f * L2E;
    u32x4 kreg, vreg, rreg = {};
#define ATT_TILE(i) (SB ? (jhi - (i)) : (i))
#define ATT_LOAD(j) do { kreg = *(const u32x4*)(kg + (size_t)(j) * 64 * kvpitch); vreg = *(const u32x4*)(vg + (size_t)(j) * 64 * kvpitch); if (!SB && tid < 256) rreg = *(const u32x4*)(rg + (size_t)(j) * 64 * 32); } while (0)
#define ATT_WRITE(st) do { *(ATT_LAS u32x4*)(lds + (st) * BUF + kdst) = kreg; *(ATT_LAS u32x4*)(lds + (st) * BUF + vdst) = vreg; if (!SB && tid < 256) *(ATT_LAS u32x4*)(lds + (st) * BUF + rdst) = rreg; } while (0)
    ATT_LOAD(ATT_TILE(0)); ATT_WRITE(0);
    __syncthreads();
    bool wdone = false;
    for (int i = 0; i < ntiles; ++i) {
        const int j = ATT_TILE(i), st = i & 1;
        if (i + 1 < ntiles) ATT_LOAD(ATT_TILE(i + 1));
        if (j <= jw && !wdone) {
            ATT_LAS unsigned char* kb = lds + st * BUF;
            f32x16 s0 = {}, s1 = {};
#pragma unroll
            for (int ks = 0; ks < DKS; ++ks) {
                const bf16x8 k0 = *(const ATT_LAS bf16x8*)(kb + kfr + 32 * ks), k1 = *(const ATT_LAS bf16x8*)(kb + kfr + 32 * KSTR + 32 * ks);
                s0 = __builtin_amdgcn_mfma_f32_32x32x16_bf16(k0, qf[ks], s0, 0, 0, 0); s1 = __builtin_amdgcn_mfma_f32_32x32x16_bf16(k1, qf[ks], s1, 0, 0, 0); }
            const int key0 = 64 * j + 16 * hh;
            unsigned pw[2][8];
            if (SB) {
                const bool msk = (64 * j + 63 >= R0 + 32 * wid);
                float run1 = 0.f, run0 = 0.f;
#pragma unroll
                for (int r = 15; r >= 0; --r) { const float zl = fminf(s1[r] * CS, 126.f); float sp = __builtin_amdgcn_logf(1.f + __builtin_amdgcn_exp2f(zl)); float ls = zl - sp + run1;
                    if (msk && (key0 + 32 + r >= qrow)) { sp = 0.f; ls = -1e30f; } s1[r] = ls; run1 -= sp; }
#pragma unroll
                for (int r = 15; r >= 0; --r) { const float zl = fminf(s0[r] * CS, 126.f); float sp = __builtin_amdgcn_logf(1.f + __builtin_amdgcn_exp2f(zl)); float ls = zl - sp + run0;
                    if (msk && (key0 + r >= qrow)) { sp = 0.f; ls = -1e30f; } s0[r] = ls; run0 -= sp; }
                const float oth1 = swap_other(run1), oth0 = swap_other(run0);
                const float base1 = carry + (hh == 0 ? oth1 : 0.f);
                const float base0 = carry + run1 + oth1 + (hh == 0 ? oth0 : 0.f);
                carry += (run1 + oth1) + (run0 + oth0);
#pragma unroll
                for (int r = 0; r < 16; ++r) { s1[r] = __builtin_amdgcn_exp2f(s1[r] + base1); s0[r] = __builtin_amdgcn_exp2f(s0[r] + base0); }
            } else {
                const bool msk = (64 * j + 63 > R0 + 32 * wid);
                if (msk) {
#pragma unroll
                    for (int r = 0; r < 16; ++r) { if (key0 + r > qrow) s0[r] = -1e30f; if (key0 + 32 + r > qrow) s1[r] = -1e30f; } }
                float mx = fmaxf(s0[0], s1[0]);
#pragma unroll
                for (int r = 1; r < 16; ++r) mx = fmaxf(mx, fmaxf(s0[r], s1[r]));
                mx = fmaxf(mx, swap_other(mx));
                const float mn = fmaxf(carry, mx), alpha = __builtin_amdgcn_exp2f((carry - mn) * CS), mc = mn * CS; carry = mn;
                float ps = 0.f;
#pragma unroll
                for (int r = 0; r < 16; ++r) { s0[r] = __builtin_amdgcn_exp2f(s0[r] * CS - mc); s1[r] = __builtin_amdgcn_exp2f(s1[r] * CS - mc); ps += s0[r] + s1[r]; }
                lsum = lsum * alpha + ps;
#pragma unroll
                for (int r = 0; r < 16; ++r) { o0[r] *= alpha; o1[r] *= alpha; }
            }
#pragma unroll
            for (int t = 0; t < 8; ++t) { pw[0][t] = cvtpk(s0[2 * t], s0[2 * t + 1]); pw[1][t] = cvtpk(s1[2 * t], s1[2 * t + 1]); }
#pragma unroll
            for (int blk = 0; blk < 2; ++blk)
#pragma unroll
                for (int sx = 0; sx < 2; ++sx) {
                    const u32x4 pfu = {pw[blk][4 * sx], pw[blk][4 * sx + 1], pw[blk][4 * sx + 2], pw[blk][4 * sx + 3]}; const bf16x8 pf = __builtin_bit_cast(bf16x8, pfu);
#pragma unroll
                    for (int dblk = 0; dblk < 2; ++dblk) {
                        ATT_LAS unsigned char* vp = kb + vfr + (32 * blk + 16 * sx) * VSTR + 64 * dblk;
                        const s16x4 lo = __builtin_bit_cast(s16x4, __builtin_amdgcn_ds_read_tr16_b64_v4i16((ATT_LAS s16x4*)vp));
                        const s16x4 hi = __builtin_bit_cast(s16x4, __builtin_amdgcn_ds_read_tr16_b64_v4i16((ATT_LAS s16x4*)(vp + 8 * VSTR)));
                        const bf16x8 vf = {lo[0], lo[1], lo[2], lo[3], hi[0], hi[1], hi[2], hi[3]};
                        if (dblk == 0) o0 = __builtin_amdgcn_mfma_f32_32x32x16_bf16(vf, pf, o0, 0, 0, 0); else o1 = __builtin_amdgcn_mfma_f32_32x32x16_bf16(vf, pf, o1, 0, 0, 0);
                    }
                }
            if (SB) wdone = __all(carry < -160.f) != 0;
        }
        if (i + 1 < ntiles) ATT_WRITE(st ^ 1);
        if (SB) { if (lane == 0) flags[st * 8 + wid] = wdone ? 1 : 0; }
        __syncthreads();
        if (SB) { int all = 1;
#pragma unroll
            for (int w = 0; w < 8; ++w) all &= flags[st * 8 + w];
            if (all) break; }
    }
    float inv = 1.f;
    if (!SB) { const float lt = lsum + swap_other(lsum); inv = 1.f / lt; }
    bf16* orow = P.HM + (row0 + qrow) * D + (SB ? 64 * h : 256 + 64 * h) + 4 * hh;
#pragma unroll
    for (int g = 0; g < 4; ++g) {
        u32x2 w0, w1; w0.x = cvtpk(o0[4 * g] * inv, o0[4 * g + 1] * inv); w0.y = cvtpk(o0[4 * g + 2] * inv, o0[4 * g + 3] * inv);
        w1.x = cvtpk(o1[4 * g] * inv, o1[4 * g + 1] * inv); w1.y = cvtpk(o1[4 * g + 2] * inv, o1[4 * g + 3] * inv);
        *(u32x2*)(orow + 8 * g) = w0; *(u32x2*)(orow + 32 + 8 * g) = w1; }
    __syncthreads();
#undef ATT_TILE
#undef ATT_LOAD
#undef ATT_WRITE
}
constexpr int N_ATT_UNITS = 768;
__device__ __forceinline__ void attn_run_unit(ATT_LAS unsigned char* lds, const AttnP& P, int u) {
    if (u < 512) { const int qb = 7 - (u >> 6), bh = u & 63; attn_unit<false>(lds, P, bh >> 3, bh & 7, qb); }
    else { const int v = u - 512, qb = 7 - (v >> 5), bh = v & 31; attn_unit<true>(lds, P, bh >> 2, bh & 3, qb); }
}
}
__global__ void __launch_bounds__(512, 2) k_attn(att::AttnP P) {
    extern __shared__ __attribute__((aligned(16))) unsigned char lds[];
    att::attn_run_unit((ATT_LAS unsigned char*)lds, P, (int)blockIdx.x);
}

__global__ void __launch_bounds__(256) k_prep(Ptrs P) {
    __shared__ float scr_all[4][64 * 33];
    const int lane = threadIdx.x & 63, wv = threadIdx.x >> 6; float* scr = scr_all[wv];
    const int gw = blockIdx.x * 4 + wv, NGW = gridDim.x * 4;
    bf16* WB = (bf16*)(P.ws + WS_W);
    constexpr int I_G = (D / 64) * (FF / 32), I_D = (FF / 64) * (D / 32), I_IN = (D / 64) * (2208 / 32), I_UQ = (QRANK / 64) * (NQ / 32), I_UKV = (KVRANK / 64) * (NKV / 32),
                  I_O = (D / 64) * (D / 32), I_PP = (PLE / 64) * (D / 32);
    constexpr int I_LAYER = 6 * I_G + I_IN + I_UQ + I_UKV + 2 * I_O + I_PP;
    static_assert(I_G == I_D, "items");
    for (int it = gw; it < DEPTH * I_LAYER; it += NGW) {
        const int l = it / I_LAYER; int r = it % I_LAYER; bf16* wl = WB + (size_t)l * W_LAYER;
        const size_t oFF = (size_t)l * D * FF;
        if (r < I_G) { prep_item(P.w1_gate + oFF, D, FF, wl + WO_GU1, MAP_GATE, nullptr, scr, r, lane); continue; } r -= I_G;
        if (r < I_G) { prep_item(P.w1_up + oFF, D, FF, wl + WO_GU1, MAP_UP, nullptr, scr, r, lane); continue; } r -= I_G;
        if (r < I_D) { prep_item(P.w1_down + oFF, FF, D, wl + WO_D1, MAP_ID, nullptr, scr, r, lane); continue; } r -= I_D;
        if (r < I_G) { prep_item(P.w2_gate + oFF, D, FF, wl + WO_GU2, MAP_GATE, nullptr, scr, r, lane); continue; } r -= I_G;
        if (r < I_G) { prep_item(P.w2_up + oFF, D, FF, wl + WO_GU2, MAP_UP, nullptr, scr, r, lane); continue; } r -= I_G;
        if (r < I_D) { prep_item(P.w2_down + oFF, FF, D, wl + WO_D2, MAP_ID, nullptr, scr, r, lane); continue; } r -= I_D;
        if (r < I_IN) { prep_item(P.w_in + (size_t)l * D * 2208, D, 2208, wl + WO_IN, MAP_IN, nullptr, scr, r, lane); continue; } r -= I_IN;
        if (r < I_UQ) { prep_item(P.w_mla_uq + (size_t)l * QRANK * NQ, QRANK, NQ, wl + WO_UQ, MAP_UQ, P.g_mla_q + l * QRANK, scr, r, lane); continue; } r -= I_UQ;
        if (r < I_UKV) { prep_item(P.w_mla_ukv + (size_t)l * KVRANK * NKV, KVRANK, NKV, wl + WO_UKV, MAP_UKV, P.g_mla_kv + l * KVRANK, scr, r, lane); continue; } r -= I_UKV;
        if (r < I_O) { prep_item(P.w_out + (size_t)l * D * D, D, D, wl + WO_OUT, MAP_ID, nullptr, scr, r, lane); continue; } r -= I_O;
        if (r < I_O) { prep_item(P.w_ple_gate + (size_t)l * D * D, D, D, wl + WO_PG, MAP_ID, nullptr, scr, r, lane); continue; } r -= I_O;
        prep_item(P.w_ple_proj + (size_t)l * PLE * D, PLE, D, wl + WO_PP, MAP_ID, nullptr, scr, r, lane);
    }
    { const int gt = blockIdx.x * 256 + threadIdx.x, NT = gridDim.x * 256;
      for (int i = gt; i < DEPTH * 96 * (D / 8); i += NT) { const int l = i / (96 * (D / 8)), r = i % (96 * (D / 8)); *(u32x4*)(WB + (size_t)l * W_LAYER + WO_IN + (size_t)(1184 + r / (D / 8)) * D + (r % (D / 8)) * 8) = (u32x4){0u, 0u, 0u, 0u}; }
      float* rt = (float*)(P.ws + WS_ROPE);
      for (int i = gt; i < T * 16; i += NT) { const int t = i >> 4, j = i & 15; const double inv = pow(10000.0, -(double)j / 16.0); const double a = (double)P.pos[t] * inv; rt[t * 32 + j] = (float)cos(a); rt[t * 32 + 16 + j] = (float)sin(a); }
      float* ss = (float*)(P.ws + WS_SSQ);
      for (int i = gt; i < 4 * T; i += NT) ss[i] = 0.f; }
    bf16* HM = (bf16*)(P.ws + WS_HM);
    for (int m = gw; m < T; m += NGW) norm_row_first(P.x + (size_t)m * D, P.out + (size_t)m * D, HM + (size_t)m * D, P.g_ffn1_pre, lane);
}

__global__ void __launch_bounds__(256) k_norm_step(const bf16* Y, float* X, bf16* HM, float w, const float* g_post, const float* g_next) {
    const int lane = threadIdx.x & 63, gw = blockIdx.x * 4 + (threadIdx.x >> 6), NGW = gridDim.x * 4;
    for (int m = gw; m < T; m += NGW) norm_row_step(Y + (size_t)m * D, X + (size_t)m * D, HM + (size_t)m * D, w, g_post, g_next, lane);
}

struct GArgs { const bf16* A; int lda; const bf16* Bt; int ldb; int K; void* C; int ldc; const float* aux; float auxdim; };
template <int MODE> __global__ void __launch_bounds__(256) k_gemm(GArgs g) {
    __shared__ __attribute__((aligned(16))) bf16 sA[64][40];
    __shared__ __attribute__((aligned(16))) bf16 sB[64][40];
    const int tid = threadIdx.x, lane = tid & 63, wv = tid >> 6;
    const int m0 = blockIdx.y * 64;
    const int nbase = (MODE == 1) ? 256 * (blockIdx.x >> 2) + 32 * (blockIdx.x & 3) : blockIdx.x * 64;
#define NB(i) (nbase + ((MODE == 1) ? (((i) >> 1) * 128 + ((i) & 1) * 16) : 16 * (i)))
    f32x4 acc[4];
#pragma unroll
    for (int i = 0; i < 4; ++i) acc[i] = (f32x4){0.f, 0.f, 0.f, 0.f};
    const int sr = tid >> 2, sc = (tid & 3) * 8;
    const bf16* ap = g.A + (size_t)(m0 + sr) * g.lda + sc;
    const bf16* bp = g.Bt + (size_t)(NB(sr >> 4) + (sr & 15)) * g.ldb + sc;
    for (int k0 = 0; k0 < g.K; k0 += 32) {
        const u32x4 va = *(const u32x4*)(ap + k0), vb = *(const u32x4*)(bp + k0);
        __syncthreads();
        *(u32x4*)&sA[sr][sc] = va; *(u32x4*)&sB[sr][sc] = vb;
        __syncthreads();
        const bf16x8 a = *(const bf16x8*)&sA[16 * wv + (lane & 15)][8 * (lane >> 4)];
#pragma unroll
        for (int i = 0; i < 4; ++i) { const bf16x8 b = *(const bf16x8*)&sB[16 * i + (lane & 15)][8 * (lane >> 4)]; acc[i] = __builtin_amdgcn_mfma_f32_16x16x32_bf16(a, b, acc[i], 0, 0, 0); }
    }
#pragma unroll
    for (int r = 0; r < 4; ++r) {
        const int row = m0 + 16 * wv + 4 * (lane >> 4) + r;
        if (MODE == 1) {
#pragma unroll
            for (int i = 0; i < 2; ++i) { const float gv = acc[i][r], uv = acc[i + 2][r]; const float hv = gv / (1.f + __expf(-gv)) * uv;
                const int hcol = 128 * (blockIdx.x >> 2) + 32 * (blockIdx.x & 3) + 16 * i + (lane & 15); ((bf16*)g.C)[(size_t)row * g.ldc + hcol] = (bf16)f2bf(hv); }
        } else {
            float sc2 = 1.f; if (MODE == 2) sc2 = 1.0f / sqrtf(g.aux[row] / g.auxdim + EPS);
#pragma unroll
            for (int i = 0; i < 4; ++i) { const int col = NB(i) + (lane & 15); float v = acc[i][r];
                if (MODE == 0) ((bf16*)g.C)[(size_t)row * g.ldc + col] = (bf16)f2bf(v);
                if (MODE == 2) ((bf16*)g.C)[(size_t)row * g.ldc + col] = (bf16)f2bf(v * sc2);
                if (MODE == 3) ((float*)g.C)[(size_t)row * g.ldc + col] = v;
                if (MODE == 4) { const float e = g.aux[(size_t)row * D + col] / (1.f + __expf(-v)); ((bf16*)g.C)[(size_t)row * g.ldc + col] = (bf16)f2bf(e); } }
        }
    }
}

__global__ void __launch_bounds__(256) k_rowss(const bf16* IN, float* ssq, float* sskv) {
    const int lane = threadIdx.x & 63, gw = blockIdx.x * 4 + (threadIdx.x >> 6), NGW = gridDim.x * 4;
    for (int m = gw; m < T; m += NGW) { const bf16* r = IN + (size_t)m * NIN; float a = 0.f, b = 0.f;
        for (int c = lane; c < QRANK; c += 64) { const float v = bf2f(r[IN_CQ + c]); a += v * v; }
        for (int c = lane; c < KVRANK; c += 64) { const float v = bf2f(r[IN_CKV + c]); b += v * v; }
        a = wave_sum(a); b = wave_sum(b); if (lane == 0) { ssq[m] = a; sskv[m] = b; } }
}
__global__ void __launch_bounds__(256) k_mix_elem(const bf16* IN, const float* rt, const float* wconv, bf16* KR, bf16* HM) {
    const int gt = blockIdx.x * 256 + threadIdx.x, NT = gridDim.x * 256;
    for (int i = gt; i < T * 16; i += NT) { const int t = i >> 4, j = i & 15; const float c = rt[t * 32 + j], s = rt[t * 32 + 16 + j];
        const float x1 = bf2f(IN[(size_t)t * NIN + IN_KR + j]), x2 = bf2f(IN[(size_t)t * NIN + IN_KR + 16 + j]);
        KR[t * 32 + j] = (bf16)f2bf(x1 * c - x2 * s); KR[t * 32 + 16 + j] = (bf16)f2bf(x2 * c + x1 * s); }
    for (int i = gt; i < T * 256; i += NT) { const int t = i >> 8, c = i & 255, tt = t % SEQ; const bf16* r = IN + (size_t)t * NIN; float acc = 0.f;
#pragma unroll
        for (int j = 0; j < 3; ++j) { const int dt = 2 - j; if (tt - dt >= 0) { const bf16* rr = r - (size_t)dt * NIN; acc += wconv[j * 256 + c] * (bf2f(rr[IN_CVC + c]) * bf2f(rr[IN_CVH + c])); } }
        HM[(size_t)t * D + 768 + c] = (bf16)f2bf(bf2f(r[IN_CVB + c]) * acc); }
}
__global__ void __launch_bounds__(256) k_rope_q(bf16* QM, const float* rt) {
    const int gt = blockIdx.x * 256 + threadIdx.x, NT = gridDim.x * 256;
    for (int i = gt; i < T * 128; i += NT) { const int t = i >> 7, c = i & 127, j = c & 15; const float cs = rt[t * 32 + j], sn = rt[t * 32 + 16 + j];
        bf16* q = QM + (size_t)t * NQ; const float x1 = bf2f(q[512 + c]), x2 = bf2f(q[640 + c]);
        q[512 + c] = (bf16)f2bf(x1 * cs - x2 * sn); q[640 + c] = (bf16)f2bf(x2 * cs + x1 * sn); }
}
__global__ void __launch_bounds__(256) k_cvt_p(const float* p, bf16* P16) {
    const int gt = blockIdx.x * 256 + threadIdx.x, NT = gridDim.x * 256;
    for (int i = gt; i < T * PLE / 4; i += NT) { const f32x4 v = *(const f32x4*)(p + 4 * (size_t)i); u32x2 o; o.x = pk2(v.x, v.y); o.y = pk2(v.z, v.w); *(u32x2*)(P16 + 4 * (size_t)i) = o; }
}

__global__ void __launch_bounds__(256) k_sb_attn(const bf16* IN, bf16* HM) {
    const int b = blockIdx.z, h = blockIdx.y, t = blockIdx.x * 256 + threadIdx.x;
    const bf16* base = IN + (size_t)b * SEQ * NIN;
    float q[64], o[64];
    { const bf16* qr = base + (size_t)t * NIN + IN_SBQ + 64 * h;
#pragma unroll
      for (int d = 0; d < 64; ++d) { q[d] = bf2f(qr[d]) * 0.125f; o[d] = 0.f; } }
    const int tmax = __builtin_amdgcn_readfirstlane(blockIdx.x * 256 + (threadIdx.x | 63));
    float after = 0.f;
    for (int s = tmax - 1; s >= 0; --s) {
        const bf16* kr = base + (size_t)s * NIN + IN_SBK + 64 * h; const bf16* vr = base + (size_t)s * NIN + IN_SBV + 64 * h;
        float z = 0.f;
#pragma unroll
        for (int d = 0; d < 64; ++d) z += q[d] * bf2f(kr[d]);
        if (s < t) {
            const float l1p = log1pf(__expf(-fabsf(z)));
            const float sp = fmaxf(z, 0.f) + l1p, ls = fminf(z, 0.f) - l1p;
            const float w = __expf(ls + after); after -= sp;
#pragma unroll
            for (int d = 0; d < 64; ++d) o[d] += w * bf2f(vr[d]);
        }
    }
    bf16* orow = HM + ((size_t)b * SEQ + t) * D + 64 * h;
#pragma unroll
    for (int d = 0; d < 64; ++d) orow[d] = (bf16)f2bf(o[d]);
}
__global__ void __launch_bounds__(256) k_mla_attn(const bf16* QM, const bf16* KV, const bf16* KR, bf16* HM) {
    const int b = blockIdx.z, h = blockIdx.y, t = blockIdx.x * 256 + threadIdx.x;
    const size_t r0 = (size_t)b * SEQ;
    float q[96], o[64];
    { const bf16* qr = QM + (r0 + t) * NQ; const float sc = 0.10206207261596575f;
#pragma unroll
      for (int d = 0; d < 64; ++d) { q[d] = bf2f(qr[64 * h + d]) * sc; o[d] = 0.f; }
#pragma unroll
      for (int d = 0; d < 16; ++d) { q[64 + d] = bf2f(qr[512 + 16 * h + d]) * sc; q[80 + d] = bf2f(qr[640 + 16 * h + d]) * sc; } }
    const int tmax = __builtin_amdgcn_readfirstlane(blockIdx.x * 256 + (threadIdx.x | 63));
    float m = -1e30f, l = 0.f;
    for (int s = 0; s <= tmax; ++s) {
        const bf16* kn = KV + (r0 + s) * NKV + 64 * h; const bf16* vr = KV + (r0 + s) * NKV + 512 + 64 * h; const bf16* kr = KR + (r0 + s) * 32;
        float z = 0.f;
#pragma unroll
        for (int d = 0; d < 64; ++d) z += q[d] * bf2f(kn[d]);
#pragma unroll
        for (int d = 0; d < 32; ++d) z += q[64 + d] * bf2f(kr[d]);
        if (s <= t) {
            const float mn = fmaxf(m, z), al = __expf(m - mn), pw = __expf(z - mn);
            l = l * al + pw; m = mn;
#pragma unroll
            for (int d = 0; d < 64; ++d) o[d] = o[d] * al + pw * bf2f(vr[d]);
        }
    }
    const float il = 1.f / l;
    bf16* orow = HM + (r0 + t) * D + 256 + 64 * h;
#pragma unroll
    for (int d = 0; d < 64; ++d) orow[d] = (bf16)f2bf(o[d] * il);
}

template <int MODE> static void gemm(hipStream_t st, const bf16* A, int lda, const bf16* Bt, int ldb, int N, int K, void* C, int ldc, const float* aux, float auxdim) {
    GArgs g{A, lda, Bt, ldb, K, C, ldc, aux, auxdim};
    dim3 grid(MODE == 1 ? (N / 256) * 4 : N / 64, T / 64);
    hipLaunchKernelGGL(k_gemm<MODE>, grid, dim3(256), 0, st, g);
}

extern "C" void kernel_launch(void* const* d_in, const int* in_sizes, int n_in, void* d_out, int out_size, void* d_ws, size_t ws_size, hipStream_t stream) {
    if (n_in != 26 || out_size != T * D || ws_size < WS_END) { fprintf(stderr, "kernel_launch: unexpected shapes n_in %d out %d ws %zu\n", n_in, out_size, ws_size); return; }
    Ptrs P{};
    P.x = (const float*)d_in[0]; P.p = (const float*)d_in[1]; P.pos = (const int*)d_in[2];
    const float** f = &P.g_ffn1_pre; for (int i = 0; i < 23; ++i) f[i] = (const float*)d_in[3 + i];
    P.out = (float*)d_out; P.ws = (unsigned char*)d_ws;
    unsigned char* ws = P.ws;
    bf16* WB = (bf16*)(ws + WS_W); bf16* HM = (bf16*)(ws + WS_HM); bf16* KR = (bf16*)(ws + WS_KR); bf16* IN = (bf16*)(ws + WS_IN); bf16* QM = (bf16*)(ws + WS_QM);
    bf16* KV = (bf16*)(ws + WS_KV); bf16* HID = (bf16*)(ws + WS_HID); bf16* Y = (bf16*)(ws + WS_Y); bf16* P16 = (bf16*)(ws + WS_P16); float* PP = (float*)(ws + WS_PP);
    float* SSQ = (float*)(ws + WS_SSQ); float* SSKV = (float*)(ws + WS_SSKV); float* RT = (float*)(ws + WS_ROPE); float* X = P.out;
    hipLaunchKernelGGL(k_prep, dim3(1024), dim3(256), 0, stream, P);
    for (int l = 0; l < DEPTH; ++l) {
        bf16* wl = WB + (size_t)l * W_LAYER;
        pgemm(stream, HM, D, wl + WO_GU1, D, NGU, D, pg8::EpiGU{HID, FF, 0});
        pgemm(stream, HID, FF, wl + WO_D1, FF, D, FF, pg8::EpiStore<0>{Y, nullptr, nullptr, nullptr, nullptr, D, 0.f});
        hipLaunchKernelGGL(k_norm_step, dim3(1024), dim3(256), 0, stream, Y, X, HM, 0.5f, P.g_ffn1_post + l * D, P.g_mix_pre + l * D);
        pgemm(stream, HM, D, wl + WO_IN, D, NIN, D, pg8::EpiStore<1>{IN, SSQ + l * T, SSKV + l * T, nullptr, nullptr, NIN, 0.f});
        hipLaunchKernelGGL(k_mix_elem, dim3(1024), dim3(256), 0, stream, IN, RT, P.w_conv + l * 3 * 256, KR, HM);
        pgemm(stream, IN + IN_CQ, NIN, wl + WO_UQ, QRANK, NQ, QRANK, pg8::EpiStore<2>{QM, nullptr, nullptr, SSQ + l * T, RT, NQ, (float)QRANK});
        pgemm(stream, IN + IN_CKV, NIN, wl + WO_UKV, KVRANK, NKV, KVRANK, pg8::EpiStore<3>{KV, nullptr, nullptr, SSKV + l * T, nullptr, NKV, (float)KVRANK});
        { static bool once = false; if (!once) { once = true; (void)hipFuncSetAttribute((const void*)k_attn, hipFuncAttributeMaxDynamicSharedMemorySize, att::ATT_LDS); }
          att::AttnP AP{IN, QM, KV, KR, HM}; hipLaunchKernelGGL(k_attn, dim3(att::N_ATT_UNITS), dim3(512), att::ATT_LDS, stream, AP); }
        pgemm(stream, HM, D, wl + WO_OUT, D, D, D, pg8::EpiStore<0>{Y, nullptr, nullptr, nullptr, nullptr, D, 0.f});
        hipLaunchKernelGGL(k_norm_step, dim3(1024), dim3(256), 0, stream, Y, X, HM, 1.0f, P.g_mix_post + l * D, P.g_ffn2_pre + l * D);
        pgemm(stream, HM, D, wl + WO_GU2, D, NGU, D, pg8::EpiGU{HID, FF, 0});
        pgemm(stream, HID, FF, wl + WO_D2, FF, D, FF, pg8::EpiStore<0>{Y, nullptr, nullptr, nullptr, nullptr, D, 0.f});
        hipLaunchKernelGGL(k_norm_step, dim3(1024), dim3(256), 0, stream, Y, X, HM, 0.5f, P.g_ffn2_post + l * D, P.g_ple_pre + l * D);
        hipLaunchKernelGGL(k_cvt_p, dim3(1024), dim3(256), 0, stream, P.p + (size_t)l * T * PLE, P16);
        pgemm(stream, P16, PLE, wl + WO_PP, PLE, D, PLE, pg8::EpiPle<true>{PP, nullptr, D, 0});
        pgemm(stream, HM, D, wl + WO_PG, D, D, D, pg8::EpiPle<false>{PP, Y, D, 0});
        hipLaunchKernelGGL(k_norm_step, dim3(1024), dim3(256), 0, stream, Y, X, HM, 1.0f, P.g_ple_post + l * D, (const float*)(l + 1 < DEPTH ? P.g_ffn1_pre + (l + 1) * D : nullptr));
    }
}
```

```cpp
#include <hip/hip_runtime.h>
#include <cstdio>
#include <cstdint>
#include <cmath>

typedef unsigned short bf16;
typedef short bf16x8 __attribute__((ext_vector_type(8)));
typedef float f32x4 __attribute__((ext_vector_type(4)));
typedef unsigned u32x4 __attribute__((ext_vector_type(4)));
typedef unsigned u32x2 __attribute__((ext_vector_type(2)));

constexpr int BATCH = 8, SEQ = 2048, T = BATCH * SEQ, D = 1024, FF = 2816, DEPTH = 2;
constexpr int NGU = 2 * FF;
constexpr int NIN = 2304;
constexpr int IN_SBQ = 0, IN_SBK = 256, IN_SBV = 512, IN_CQ = 768, IN_KR = 1152, IN_CKV = 1280, IN_CVB = 1536, IN_CVC = 1792, IN_CVH = 2048;
constexpr int QRANK = 384, KVRANK = 256, NQ = 768, NKV = 1024, PLE = 256;
constexpr float EPS = 1e-6f;

constexpr size_t MiB = 1u << 20;
constexpr size_t WS_CTL = 0;
constexpr size_t WS_SSQ = 1 * MiB;
constexpr size_t WS_SSKV = WS_SSQ + 2 * T * 4;
constexpr size_t WS_ROPE = 2 * MiB;
constexpr size_t WS_W = 4 * MiB;
constexpr size_t WO_GU1 = 0, WO_D1 = WO_GU1 + (size_t)NGU * D, WO_GU2 = WO_D1 + (size_t)D * FF, WO_D2 = WO_GU2 + (size_t)NGU * D,
                 WO_IN = WO_D2 + (size_t)D * FF, WO_UQ = WO_IN + (size_t)NIN * D, WO_UKV = WO_UQ + (size_t)NQ * QRANK,
                 WO_OUT = WO_UKV + (size_t)NKV * KVRANK, WO_PG = WO_OUT + (size_t)D * D, WO_PP = WO_PG + (size_t)D * D,
                 W_LAYER = WO_PP + (size_t)D * PLE;
constexpr size_t WS_HM = 92 * MiB;
constexpr size_t WS_KR = 124 * MiB;
constexpr size_t WS_REG = 125 * MiB;
constexpr size_t WS_IN = WS_REG, WS_QM = WS_REG + 72 * MiB, WS_KV = WS_REG + 96 * MiB;
constexpr size_t WS_HID = WS_REG, WS_Y = WS_REG + 88 * MiB, WS_P16 = WS_REG + 120 * MiB;
constexpr size_t WS_PP = WS_REG;
constexpr size_t WS_END = WS_REG + 128 * MiB;
static_assert(WS_W + 2 * W_LAYER * 2 <= WS_HM, "weights fit");

__device__ __forceinline__ unsigned f2bf(float f) { unsigned u = __float_as_uint(f); return (u + 0x7fffu + ((u >> 16) & 1u)) >> 16; }
__device__ __forceinline__ unsigned pk2(float lo, float hi) { return f2bf(lo) | (f2bf(hi) << 16); }
__device__ __forceinline__ float bf2f(unsigned short b) { return __uint_as_float((unsigned)b << 16); }
__device__ __forceinline__ float wave_sum(float v) {
#pragma unroll
    for (int o = 1; o < 64; o <<= 1) v += __shfl_xor(v, o);
    return v;
}

__device__ __forceinline__ int lane_id_v() { int l; asm volatile("v_mbcnt_lo_u32_b32 %0, -1, 0\n\tv_mbcnt_hi_u32_b32 %0, -1, %0" : "=v"(l)); return l; }
__device__ __forceinline__ int wave_id_s() { return __builtin_amdgcn_readfirstlane((int)threadIdx.x >> 6); }
enum { MAP_ID = 0, MAP_GATE, MAP_UP, MAP_IN, MAP_UQ, MAP_UKV };
__device__ __forceinline__ int dmap(int kind, int c) {
    switch (kind) {
        case MAP_GATE: return 256 * (c >> 7) + (c & 127);
        case MAP_UP:   return 256 * (c >> 7) + 128 + (c & 127);
        case MAP_IN:   return c < 1152 ? c : (c < 1408 ? IN_CKV + (c - 1152) : (c < 1440 ? IN_KR + (c - 1408) : IN_CVB + (c - 1440)));
        case MAP_UQ:   { const int h = c / 96, d = c % 96; return d < 64 ? 64 * h + d : (d < 80 ? 512 + 16 * h + (d - 64) : 640 + 16 * h + (d - 80)); }
        case MAP_UKV:  { const int h = c >> 7, d = c & 127; return d < 64 ? 64 * h + d : 512 + 64 * h + (d - 64); }
        default: return c;
    }
}
__device__ __forceinline__ void prep_item(const float* W, int K, int Nsrc, bf16* WT, int kind, const float* gain, float* scr, int item, int lane) {
    const int nblk = Nsrc / 32, kb = item / nblk, nb = item % nblk, k0 = 64 * kb, n0 = 32 * nb;
#pragma unroll 8
    for (int i = 0; i < 32; ++i) { const int kk = 2 * i + (lane >> 5); float v = W[(size_t)(k0 + kk) * Nsrc + n0 + (lane & 31)]; if (gain) v *= gain[k0 + kk]; scr[kk * 33 + (lane & 31)] = v; }
    __builtin_amdgcn_s_waitcnt(0xc07f); __builtin_amdgcn_wave_barrier();
    const int c = lane & 7;
#pragma unroll
    for (int j = 0; j < 4; ++j) { const int n = (lane >> 3) + 8 * j; const float* s = scr + (8 * c) * 33 + n;
        u32x4 o; o.x = pk2(s[0 * 33], s[1 * 33]); o.y = pk2(s[2 * 33], s[3 * 33]); o.z = pk2(s[4 * 33], s[5 * 33]); o.w = pk2(s[6 * 33], s[7 * 33]);
        *(u32x4*)(WT + (size_t)dmap(kind, n0 + n) * K + k0 + 8 * c) = o; }
    __builtin_amdgcn_s_waitcnt(0xc07f); __builtin_amdgcn_wave_barrier();
}

struct Ptrs {
    const float* x; const float* p; const int* pos;
    const float *g_ffn1_pre, *w1_gate, *w1_up, *w1_down, *g_ffn1_post, *g_mix_pre, *w_in, *g_mla_q, *w_mla_uq, *g_mla_kv, *w_mla_ukv, *w_conv, *w_out,
                *g_mix_post, *g_ffn2_pre, *w2_gate, *w2_up, *w2_down, *g_ffn2_post, *g_ple_pre, *w_ple_gate, *w_ple_proj, *g_ple_post;
    float* out; unsigned char* ws;
};

__device__ __forceinline__ void norm_row_first(const float* xrow, float* Xrow, bf16* hrow, const float* g, int lane) {
    f32x4 v[4]; float s = 0.f;
#pragma unroll
    for (int j = 0; j < 4; ++j) { v[j] = *(const f32x4*)(xrow + 4 * lane + 256 * j); s += (v[j].x * v[j].x + v[j].y * v[j].y) + (v[j].z * v[j].z + v[j].w * v[j].w); }
    const float r = 1.0f / sqrtf(wave_sum(s) * (1.f / D) + EPS);
#pragma unroll
    for (int j = 0; j < 4; ++j) { *(f32x4*)(Xrow + 4 * lane + 256 * j) = v[j]; const f32x4 gg = *(const f32x4*)(g + 4 * lane + 256 * j);
        u32x2 o; o.x = pk2(v[j].x * r * gg.x, v[j].y * r * gg.y); o.y = pk2(v[j].z * r * gg.z, v[j].w * r * gg.w); *(u32x2*)(hrow + 4 * lane + 256 * j) = o; }
}
__device__ __forceinline__ void norm_row_step(const bf16* yrow, float* Xrow, bf16* hrow, float w, const float* g_post, const float* g_next, int lane) {
    f32x4 y[4], x[4]; float s = 0.f;
#pragma unroll
    for (int j = 0; j < 4; ++j) { const u32x2 u = *(const u32x2*)(yrow + 4 * lane + 256 * j);
        y[j].x = __uint_as_float(u.x << 16); y[j].y = __uint_as_float(u.x & 0xffff0000u); y[j].z = __uint_as_float(u.y << 16); y[j].w = __uint_as_float(u.y & 0xffff0000u);
        s += (y[j].x * y[j].x + y[j].y * y[j].y) + (y[j].z * y[j].z + y[j].w * y[j].w); }
    const float r = w / sqrtf(wave_sum(s) * (1.f / D) + EPS); float s2 = 0.f;
#pragma unroll
    for (int j = 0; j < 4; ++j) { const f32x4 gg = *(const f32x4*)(g_post + 4 * lane + 256 * j); x[j] = *(const f32x4*)(Xrow + 4 * lane + 256 * j);
        x[j].x += y[j].x * r * gg.x; x[j].y += y[j].y * r * gg.y; x[j].z += y[j].z * r * gg.z; x[j].w += y[j].w * r * gg.w;
        *(f32x4*)(Xrow + 4 * lane + 256 * j) = x[j]; s2 += (x[j].x * x[j].x + x[j].y * x[j].y) + (x[j].z * x[j].z + x[j].w * x[j].w); }
    if (g_next) { const float r2 = 1.0f / sqrtf(wave_sum(s2) * (1.f / D) + EPS);
#pragma unroll
        for (int j = 0; j < 4; ++j) { const f32x4 gg = *(const f32x4*)(g_next + 4 * lane + 256 * j);
            u32x2 o; o.x = pk2(x[j].x * r2 * gg.x, x[j].y * r2 * gg.y); o.y = pk2(x[j].z * r2 * gg.z, x[j].w * r2 * gg.w); *(u32x2*)(hrow + 4 * lane + 256 * j) = o; } }
}

namespace pg8 {
#define PG8_LAS __attribute__((address_space(3)))
typedef unsigned short bf16_t;
typedef short bf16x8 __attribute__((ext_vector_type(8)));
typedef float f32x4 __attribute__((ext_vector_type(4)));
typedef unsigned u32x4 __attribute__((ext_vector_type(4)));
constexpr int BM = 256, BK = 64, HALF = 128, HTB = HALF * BK * 2  , STAGE_BYTES = 8 * HTB, NXCD = 8, WGM = 8;

__host__ __device__ __forceinline__ int lds_byte(int r, int c) { const int st = (r >> 4) * 2 + (c >> 5), rr = r & 15, cc = c & 31, ob = rr * 64 + cc * 2; return st * 1024 + (ob ^ (((ob >> 9) & 1) << 5)); }
__host__ __device__ __forceinline__ void stage_rc(int b, int& R, int& C) { const int st = b / 1024, sb = b % 1024, swz = sb ^ (((sb >> 9) & 1) << 5); R = (st >> 1) * 16 + swz / 64; C = (st & 1) * 32 + (swz % 64) / 2; }
__host__ __device__ __forceinline__ int perm32(int rho) { const int n = rho >> 4, i = rho & 15; return 8 * (i >> 2) + 4 * n + (i & 3); }

struct Unit { int pm, pn; };
struct Gemm { const bf16_t* A; const bf16_t* Bt; int M, N, K, lda, ldb, pad; };

struct StaticOrder {
    int nM, nN, nwg, G, c;
    __host__ __device__ void init(int M, int N, int G_, int c_) { nM = M / BM; nN = N / BM; nwg = nM * nN; G = G_; c = c_; }
    __host__ __device__ bool next(int i, Unit& u) const {
        const long L = (long)i * G + c; if (L >= nwg) return false;
        int wgid = (int)L; { const int q = nwg / NXCD, r = nwg % NXCD, xcd = wgid % NXCD, off = wgid / NXCD; wgid = (xcd < r ? xcd * (q + 1) : r * (q + 1) + (xcd - r) * q) + off; }
        const int nig = WGM * nN, gid = wgid / nig, fm = gid * WGM, gsz = (nM - fm) < WGM ? (nM - fm) : WGM;
        u.pm = fm + ((wgid % nig) % gsz); u.pn = (wgid % nig) / gsz; return true;
    }
    __device__ __forceinline__ void a_ready(const Unit&) const {}
    __device__ __forceinline__ void done(const Unit&) const {}
};


template <class Epi, class Sched, bool ALIGN_EPI = false, bool SP2 = false>
__device__ __forceinline__ void gemm_phase(PG8_LAS unsigned char* lds, const Gemm g, const Sched& S, const Epi& E, int wave_s) {
    const int lane = lane_id_v(), wid = wave_s, tid = wid * 64 + lane,
              wr = wid >> 2, wc = wid & 3, fr = lane & 15, fq = lane >> 4;
    const int K = g.K, nt = K / BK;
    unsigned voffA[2], voffB[2];
#pragma unroll
    for (int i = 0; i < 2; ++i) { int R, C; stage_rc(tid * 16 + i * 8192, R, C); const int Rb = Epi::PERM ? ((R & ~31) + perm32(R & 31)) : R;
        voffA[i] = (unsigned)(R * g.lda + C) * 2u; voffB[i] = (unsigned)(Rb * g.ldb + C) * 2u; }
    const size_t kstep = (size_t)(BK * 2);
    const size_t hstepA = (size_t)HALF * g.lda * 2, hstepB = (size_t)HALF * g.ldb * 2;
    const size_t tstepA = 2 * hstepA, tstepB = 2 * hstepB;
    const unsigned ldsw = (unsigned)wid * 1024u;
    const int aoff = lds_byte(wr * 64 + fr, fq * 8), boff = lds_byte(wc * 32 + fr, fq * 8);
#define PG8_SA(b, h) (((b) * 2 + (h)) * HTB)
#define PG8_SB(b, h) ((4 + (b) * 2 + (h)) * HTB)
#define PG8_STAGE(bufoff, gbase, voff) do { _Pragma("unroll") for (int _i = 0; _i < 2; ++_i) \
        __builtin_amdgcn_global_load_lds((const unsigned*)((const char*)(gbase) + (voff)[_i]), (PG8_LAS unsigned*)(lds + (bufoff) + ldsw + _i * 8192), 16, 0, 0); } while (0)
#define PG8_LDA(dst, b, h) do { _Pragma("unroll") for (int m = 0; m < 4; ++m) _Pragma("unroll") for (int k = 0; k < 2; ++k) dst[m][k] = *(const PG8_LAS bf16x8*)(lds + PG8_SA(b, h) + aoff + m * 2048 + k * 1024); } while (0)
#define PG8_LDB(dst, b, h) do { _Pragma("unroll") for (int n = 0; n < 2; ++n) _Pragma("unroll") for (int k = 0; k < 2; ++k) dst[n][k] = *(const PG8_LAS bf16x8*)(lds + PG8_SB(b, h) + boff + n * 2048 + k * 1024); } while (0)
#define PG8_MMA(ai, bj, At, Bt) do { __builtin_amdgcn_s_setprio(1); _Pragma("unroll") for (int m = 0; m < 4; ++m) _Pragma("unroll") for (int n = 0; n < 2; ++n) _Pragma("unroll") for (int k = 0; k < 2; ++k) \
        acc[ai][bj][m][n] = __builtin_amdgcn_mfma_f32_16x16x32_bf16(Bt[n][k], At[m][k], acc[ai][bj][m][n], 0, 0, 0); __builtin_amdgcn_s_setprio(0); } while (0)
#define PG8_WAIT_V(n) asm volatile("s_waitcnt vmcnt(" #n ")" ::: "memory")
#define PG8_WAIT_L(n) asm volatile("s_waitcnt lgkmcnt(" #n ")" ::: "memory")
#define PG8_BAR __builtin_amdgcn_s_barrier()
#define PG8_SCHED __builtin_amdgcn_sched_barrier(0)
    Unit cur, nxt; int ui = 0;
    if (!S.next(0, cur)) return;
    f32x4 acc[2][2][4][2];
#pragma unroll
    for (int a = 0; a < 2; ++a)
#pragma unroll
        for (int b = 0; b < 2; ++b)
#pragma unroll
            for (int m = 0; m < 4; ++m)
#pragma unroll
                for (int n = 0; n < 2; ++n) acc[a][b][m][n] = (f32x4){0.f, 0.f, 0.f, 0.f};
    bf16x8 At[4][2], B0[2][2], B1[2][2];
    const char* cA = (const char*)g.A + (size_t)cur.pm * tstepA; const char* cB = (const char*)g.Bt + (size_t)cur.pn * tstepB;
    S.a_ready(cur);
    if constexpr (SP2) {
        PG8_STAGE(PG8_SB(0, 0), cB, voffB); PG8_STAGE(PG8_SB(0, 1), cB + hstepB, voffB); PG8_STAGE(PG8_SA(0, 0), cA, voffA); PG8_STAGE(PG8_SA(0, 1), cA + hstepA, voffA);
        if (wr == 1) PG8_BAR;
        PG8_WAIT_V(2); PG8_BAR;
        PG8_STAGE(PG8_SB(1, 0), cB + kstep, voffB); PG8_STAGE(PG8_SA(1, 0), cA + kstep, voffA); PG8_STAGE(PG8_SB(1, 1), cB + hstepB + kstep, voffB);
        PG8_WAIT_V(6); PG8_BAR;
    } else {
        PG8_STAGE(PG8_SB(0, 0), cB, voffB); PG8_STAGE(PG8_SA(0, 0), cA, voffA); PG8_STAGE(PG8_SB(0, 1), cB + hstepB, voffB); PG8_STAGE(PG8_SA(0, 1), cA + hstepA, voffA);
        if (wr == 1) PG8_BAR;
        PG8_WAIT_V(4); PG8_BAR;
        PG8_STAGE(PG8_SB(1, 0), cB + kstep, voffB); PG8_STAGE(PG8_SA(1, 0), cA + kstep, voffA); PG8_STAGE(PG8_SB(1, 1), cB + hstepB + kstep, voffB);
        PG8_WAIT_V(6); PG8_BAR;
    }
    for (;;) {
        const bool has_next = S.next(ui + 1, nxt);
        const char* nA = has_next ? (const char*)g.A + (size_t)nxt.pm * tstepA : cA; const char* nB = has_next ? (const char*)g.Bt + (size_t)nxt.pn * tstepB : cB;
        for (int t = 0; t < nt; t += 2) {
            const bool last = (t == nt - 2);
            const char* a1 = cA + (size_t)(t + 1) * kstep;
            const char* a2 = last ? nA : cA + (size_t)(t + 2) * kstep; const char* b2 = last ? nB : cB + (size_t)(t + 2) * kstep;
            const char* a3 = a2 + kstep; const char* b3 = b2 + kstep;
            if (last && has_next) S.a_ready(nxt);
            if constexpr (SP2) {
            PG8_LDB(B0, 0, 0); PG8_LDB(B1, 0, 1); PG8_SCHED; PG8_LDA(At, 0, 0); PG8_STAGE(PG8_SA(1, 1), a1 + hstepA, voffA);
            PG8_WAIT_V(8); PG8_WAIT_L(0); PG8_BAR; PG8_MMA(0, 0, At, B0); PG8_MMA(0, 1, At, B1); PG8_BAR; PG8_SCHED;
            PG8_LDA(At, 0, 1); PG8_STAGE(PG8_SB(0, 0), b2, voffB); PG8_STAGE(PG8_SB(0, 1), b2 + hstepB, voffB); PG8_STAGE(PG8_SA(0, 0), a2, voffA);
            PG8_WAIT_V(8); PG8_WAIT_L(0); PG8_BAR; PG8_MMA(1, 0, At, B0); PG8_MMA(1, 1, At, B1); PG8_BAR; PG8_SCHED;
            PG8_LDB(B0, 1, 0); PG8_LDB(B1, 1, 1); PG8_SCHED; PG8_LDA(At, 1, 0); PG8_STAGE(PG8_SA(0, 1), a2 + hstepA, voffA);
            PG8_WAIT_V(8); PG8_WAIT_L(0); PG8_BAR; PG8_MMA(0, 0, At, B0); PG8_MMA(0, 1, At, B1); PG8_BAR; PG8_SCHED;
            PG8_LDA(At, 1, 1); PG8_STAGE(PG8_SB(1, 0), b3, voffB); PG8_STAGE(PG8_SB(1, 1), b3 + hstepB, voffB); PG8_STAGE(PG8_SA(1, 0), a3, voffA);
            PG8_WAIT_V(8); PG8_WAIT_L(0); PG8_BAR; PG8_MMA(1, 0, At, B0); PG8_MMA(1, 1, At, B1); PG8_BAR; PG8_SCHED;
            } else {
            PG8_LDB(B0, 0, 0); PG8_SCHED; PG8_LDA(At, 0, 0); PG8_STAGE(PG8_SA(1, 1), a1 + hstepA, voffA);
            PG8_WAIT_L(8); PG8_BAR; PG8_WAIT_L(0); PG8_MMA(0, 0, At, B0); PG8_BAR; PG8_SCHED;
            PG8_LDB(B1, 0, 1); PG8_STAGE(PG8_SB(0, 0), b2, voffB);
            PG8_BAR; PG8_WAIT_L(0); PG8_MMA(0, 1, At, B1); PG8_BAR;
            PG8_LDA(At, 0, 1); PG8_STAGE(PG8_SA(0, 0), a2, voffA);
            PG8_BAR; PG8_WAIT_L(0); PG8_MMA(1, 0, At, B0); PG8_BAR; PG8_SCHED;
            PG8_STAGE(PG8_SB(0, 1), b2 + hstepB, voffB);
            PG8_WAIT_V(6); PG8_BAR; PG8_MMA(1, 1, At, B1); PG8_BAR;
            PG8_LDB(B0, 1, 0); PG8_SCHED; PG8_LDA(At, 1, 0); PG8_STAGE(PG8_SA(0, 1), a2 + hstepA, voffA);
            PG8_WAIT_L(8); PG8_BAR; PG8_WAIT_L(0); PG8_MMA(0, 0, At, B0); PG8_BAR; PG8_SCHED;
            PG8_LDB(B1, 1, 1); PG8_STAGE(PG8_SB(1, 0), b3, voffB);
            PG8_BAR; PG8_WAIT_L(0); PG8_MMA(0, 1, At, B1); PG8_BAR;
            PG8_LDA(At, 1, 1); PG8_STAGE(PG8_SA(1, 0), a3, voffA);
            PG8_BAR; PG8_WAIT_L(0); PG8_MMA(1, 0, At, B0); PG8_BAR; PG8_SCHED;
            PG8_STAGE(PG8_SB(1, 1), b3 + hstepB, voffB);
            PG8_WAIT_V(6); PG8_BAR; PG8_MMA(1, 1, At, B1); PG8_BAR;
            }
        }
        if constexpr (ALIGN_EPI) { if (wr == 0) PG8_BAR; }
        if constexpr (!Epi::AFTER_DRAIN) { const int l2_ = lane_id_v(); E(acc, cur, wr, wc, l2_ & 15, l2_ >> 4); S.done(cur); }
        if (!has_next) break;
#pragma unroll
        for (int a = 0; a < 2; ++a)
#pragma unroll
            for (int b = 0; b < 2; ++b)
#pragma unroll
                for (int m = 0; m < 4; ++m)
#pragma unroll
                    for (int n = 0; n < 2; ++n) acc[a][b][m][n] = (f32x4){0.f, 0.f, 0.f, 0.f};
        cur = nxt; cA = nA; cB = nB; ++ui;
        if constexpr (ALIGN_EPI) { if (wr == 1) PG8_BAR; }
    }
    PG8_WAIT_V(0);
    if constexpr (!ALIGN_EPI) { if (wr == 0) PG8_BAR; }
    PG8_BAR;
    if constexpr (Epi::AFTER_DRAIN) { const int l2_ = lane_id_v(); E.fused(acc, cur, wr, wc, l2_ & 15, l2_ >> 4, lds, wid, l2_); S.done(cur); }
#undef PG8_SA
#undef PG8_SB
#undef PG8_STAGE
#undef PG8_LDA
#undef PG8_LDB
#undef PG8_MMA
#undef PG8_WAIT_V
#undef PG8_WAIT_L
#undef PG8_BAR
#undef PG8_SCHED
}
}

namespace pg8 {
__device__ __forceinline__ unsigned cvt_pk_bf16(float lo, float hi) { unsigned r; asm volatile("v_cvt_pk_bf16_f32 %0, %1, %2" : "=v"(r) : "v"(lo), "v"(hi)); return r; }
__device__ __forceinline__ float silu_f(float x) { return x * __builtin_amdgcn_rcpf(1.f + __builtin_amdgcn_exp2f(-1.4426950408889634f * x)); }
__device__ __forceinline__ float sigmoid_f(float x) { return __builtin_amdgcn_rcpf(1.f + __builtin_amdgcn_exp2f(-1.4426950408889634f * x)); }
__device__ __forceinline__ u32x4 pack8(const f32x4& a, const f32x4& b) { u32x4 w; w.x = cvt_pk_bf16(a[0], a[1]); w.y = cvt_pk_bf16(a[2], a[3]); w.z = cvt_pk_bf16(b[0], b[1]); w.w = cvt_pk_bf16(b[2], b[3]); return w; }
struct EpiGU {
    static constexpr bool PERM = true, AFTER_DRAIN = false;
    bf16_t* H; int ldh, pad;
    __device__ __forceinline__ void operator()(const f32x4 (&acc)[2][2][4][2], const Unit& u, int wr, int wc, int fr, int fq) const {
        const int row0 = u.pm * BM + wr * 64 + fr, col0 = u.pn * HALF + wc * 32 + 8 * fq;
#pragma unroll
        for (int ai = 0; ai < 2; ++ai)
#pragma unroll
            for (int m = 0; m < 4; ++m) { bf16_t* rowp = H + (size_t)(row0 + ai * HALF + m * 16) * ldh + col0;
                f32x4 h0, h1;
#pragma unroll
                for (int j = 0; j < 4; ++j) { h0[j] = silu_f(acc[ai][0][m][0][j]) * acc[ai][1][m][0][j]; h1[j] = silu_f(acc[ai][0][m][1][j]) * acc[ai][1][m][1][j]; }
                *(u32x4*)rowp = pack8(h0, h1); }
    }
};
template <int KIND> struct EpiStore {
    static constexpr bool PERM = true, AFTER_DRAIN = false;
    bf16_t* O; float* ssq; float* sskv; const float* ss; const float* rt; int ldc; float ssdim;
    __device__ __forceinline__ void operator()(const f32x4 (&acc)[2][2][4][2], const Unit& u, int wr, int wc, int fr, int fq) const {
        const int row0 = u.pm * BM + wr * 64 + fr, col0 = u.pn * BM + wc * 32 + 8 * fq;
#pragma unroll
        for (int ai = 0; ai < 2; ++ai)
#pragma unroll
            for (int m = 0; m < 4; ++m) { const int row = row0 + ai * HALF + m * 16; bf16_t* rowp = O + (size_t)row * ldc + col0;
                f32x4 v[2][2];
#pragma unroll
                for (int bj = 0; bj < 2; ++bj) { v[bj][0] = acc[ai][bj][m][0]; v[bj][1] = acc[ai][bj][m][1]; }
                if (KIND == 2 || KIND == 3) { const float sc = 1.0f / sqrtf(ss[row] / ssdim + 1e-6f);
#pragma unroll
                    for (int bj = 0; bj < 2; ++bj) { v[bj][0] = v[bj][0] * sc; v[bj][1] = v[bj][1] * sc; } }
                if (KIND == 2) { if (u.pn == 2) {
#pragma unroll
                    for (int n = 0; n < 2; ++n) { const f32x4 cs = *(const f32x4*)(rt + (size_t)row * 32 + 8 * (fq & 1) + 4 * n), sn = *(const f32x4*)(rt + (size_t)row * 32 + 16 + 8 * (fq & 1) + 4 * n);
                        const f32x4 x1 = v[0][n], x2 = v[1][n]; v[0][n] = x1 * cs - x2 * sn; v[1][n] = x2 * cs + x1 * sn; } } }
                if (KIND == 1) { if (u.pn >= 3 && u.pn <= 5) { float part = 0.f;
#pragma unroll
                    for (int bj = 0; bj < 2; ++bj) if (bj == 0 || u.pn != 4)
#pragma unroll
                        for (int n = 0; n < 2; ++n) { const f32x4 x = v[bj][n]; part += (x[0] * x[0] + x[1] * x[1]) + (x[2] * x[2] + x[3] * x[3]); }
                    part += __shfl_xor(part, 16); part += __shfl_xor(part, 32);
                    if (fq == 0) atomicAdd((u.pn == 5 ? sskv : ssq) + row, part); } }
#pragma unroll
                for (int bj = 0; bj < 2; ++bj) *(u32x4*)(rowp + bj * HALF) = pack8(v[bj][0], v[bj][1]); }
    }
};
template <bool FIRST> struct EpiPle {
    static constexpr bool PERM = true, AFTER_DRAIN = false;
    float* PP; bf16_t* E; int ldc, pad;
    __device__ __forceinline__ void operator()(const f32x4 (&acc)[2][2][4][2], const Unit& u, int wr, int wc, int fr, int fq) const {
        const int row0 = u.pm * BM + wr * 64 + fr, col0 = u.pn * BM + wc * 32 + 8 * fq;
#pragma unroll
        for (int ai = 0; ai < 2; ++ai)
#pragma unroll
            for (int m = 0; m < 4; ++m) { const size_t off = (size_t)(row0 + ai * HALF + m * 16) * ldc + col0;
#pragma unroll
                for (int bj = 0; bj < 2; ++bj) {
                    if (FIRST) { *(f32x4*)(PP + off + bj * HALF) = acc[ai][bj][m][0]; *(f32x4*)(PP + off + bj * HALF + 4) = acc[ai][bj][m][1]; }
                    else { const f32x4 p0 = *(const f32x4*)(PP + off + bj * HALF), p1 = *(const f32x4*)(PP + off + bj * HALF + 4); f32x4 e0, e1;
#pragma unroll
                        for (int j = 0; j < 4; ++j) { e0[j] = sigmoid_f(acc[ai][bj][m][0][j]) * p0[j]; e1[j] = sigmoid_f(acc[ai][bj][m][1][j]) * p1[j]; }
                        *(u32x4*)(E + off + bj * HALF) = pack8(e0, e1); } } }
    }
};
}
namespace att {
#define ATT_LAS __attribute__((address_space(3)))
typedef float f32x16 __attribute__((ext_vector_type(16)));
typedef short s16x4 __attribute__((ext_vector_type(4)));
typedef float f32x2_t __attribute__((ext_vector_type(2)));
typedef __bf16 bf16x2_t __attribute__((ext_vector_type(2)));
__device__ __forceinline__ unsigned cvtpk(float lo, float hi) { f32x2_t v = {lo, hi}; bf16x2_t b = __builtin_convertvector(v, bf16x2_t); return __builtin_bit_cast(unsigned, b); }
__device__ __forceinline__ int rho(int kp) { const int h = kp >> 4, r = kp & 15; return (r & 3) + 8 * (r >> 2) + 4 * h; }
__device__ __forceinline__ float swap_other(float v, int hh) { auto rr = __builtin_amdgcn_permlane32_swap(__float_as_uint(v), __float_as_uint(v), false, false);
    return hh ? __uint_as_float(rr[0]) : __uint_as_float(rr[1]); }
struct AttnP { const bf16* IN; const bf16* QM; const bf16* KV; const bf16* KR; bf16* HM; };
constexpr int VSTR = 192;
constexpr int ATT_LDS = 2 * 64 * (208 + VSTR) + 64;
constexpr float L2E = 1.4426950408889634f;

template <bool SB> __device__ __forceinline__ void attn_unit(ATT_LAS unsigned char* lds, const AttnP& P, int b, int h, int qb, int wave_s) {
    constexpr int DKS = SB ? 4 : 6, KSTR = SB ? 144 : 208, KBUF = 64 * KSTR, VBUF = 64 * VSTR, BUF = KBUF + VBUF;
    const int lane = lane_id_v(), wid = wave_s, tid = wid * 64 + lane, r32 = lane & 31, hh = lane >> 5;
    const size_t row0 = (size_t)b * SEQ;
    const int R0 = qb * 256, qrow = R0 + 32 * wid + r32;
    ATT_LAS int* flags = (ATT_LAS int*)(lds + 2 * 64 * (208 + VSTR));
    bf16x8 qf[DKS];
    if (SB) { const bf16* q = P.IN + (row0 + qrow) * NIN + IN_SBQ + 64 * h;
#pragma unroll
        for (int ks = 0; ks < 4; ++ks) qf[ks] = *(const bf16x8*)(q + 16 * ks + 8 * hh); }
    else { const bf16* q = P.QM + (row0 + qrow) * NQ;
#pragma unroll
        for (int ks = 0; ks < 4; ++ks) qf[ks] = *(const bf16x8*)(q + 64 * h + 16 * ks + 8 * hh);
        qf[DKS - 2] = *(const bf16x8*)(q + 512 + 16 * h + 8 * hh); qf[DKS - 1] = *(const bf16x8*)(q + 640 + 16 * h + 8 * hh); }
    const int skey = tid >> 3, sch = tid & 7, srow = 32 * (skey >> 5) + rho(skey & 31);
    const int rkey = (tid >> 2) & 63, rrow = 32 * (rkey >> 5) + rho(rkey & 31);
    const bf16* kg = SB ? P.IN + (row0 + skey) * NIN + IN_SBK + 64 * h + 8 * sch : P.KV + (row0 + skey) * NKV + 64 * h + 8 * sch;
    const bf16* vg = SB ? P.IN + (row0 + skey) * NIN + IN_SBV + 64 * h + 8 * sch : P.KV + (row0 + skey) * NKV + 512 + 64 * h + 8 * sch;
    const bf16* rg = P.KR + (row0 + rkey) * 32 + 8 * (tid & 3);
    const size_t kvpitch = SB ? NIN : NKV;
    const int kdst = srow * KSTR + 16 * sch, vdst = KBUF + srow * VSTR + 16 * sch, rdst = rrow * KSTR + 128 + 16 * (tid & 3);
    const int jhi = 4 * qb + 3, ntiles = jhi + 1, jw = 4 * qb + (wid >> 1);
    const int kfr = r32 * KSTR + 16 * hh;
    const int vfr = KBUF + (4 * hh + ((lane & 15) >> 2)) * VSTR + (16 * ((lane >> 4) & 1) + 4 * (lane & 3)) * 2;
    f32x16 o0 = {}, o1 = {};
    float carry = 0.f;
    float lsum = 0.f;
    if (!SB) carry = -1e30f;
    constexpr float CS = SB ? 0.125f * L2E : 0.10206207261596575f * L2E;
    u32x4 kreg, vreg, rreg = {};
#define ATT_TILE(i) (SB ? (jhi - (i)) : (i))
#define ATT_LOAD(j) do { kreg = *(const u32x4*)(kg + (size_t)(j) * 64 * kvpitch); vreg = *(const u32x4*)(vg + (size_t)(j) * 64 * kvpitch); if (!SB && tid < 256) rreg = *(const u32x4*)(rg + (size_t)(j) * 64 * 32); } while (0)
#define ATT_WRITE(st) do { *(ATT_LAS u32x4*)(lds + (st) * BUF + kdst) = kreg; *(ATT_LAS u32x4*)(lds + (st) * BUF + vdst) = vreg; if (!SB && tid < 256) *(ATT_LAS u32x4*)(lds + (st) * BUF + rdst) = rreg; } while (0)
    ATT_LOAD(ATT_TILE(0)); ATT_WRITE(0);
    __syncthreads();
    bool wdone = false;
    for (int i = 0; i < ntiles; ++i) {
        const int j = ATT_TILE(i), st = i & 1;
        if (i + 1 < ntiles) ATT_LOAD(ATT_TILE(i + 1));
        if (j <= jw && !wdone) {
            ATT_LAS unsigned char* kb = lds + st * BUF;
            f32x16 s0 = {}, s1 = {};
#pragma unroll
            for (int ks = 0; ks < DKS; ++ks) {
                const bf16x8 k0 = *(const ATT_LAS bf16x8*)(kb + kfr + 32 * ks), k1 = *(const ATT_LAS bf16x8*)(kb + kfr + 32 * KSTR + 32 * ks);
                s0 = __builtin_amdgcn_mfma_f32_32x32x16_bf16(k0, qf[ks], s0, 0, 0, 0); s1 = __builtin_amdgcn_mfma_f32_32x32x16_bf16(k1, qf[ks], s1, 0, 0, 0); }
            const int key0 = 64 * j + 16 * hh;
            unsigned pw[2][8];
            if (SB) {
                const bool msk = (64 * j + 63 >= R0 + 32 * wid);
                float run1 = 0.f, run0 = 0.f;
#pragma unroll
                for (int r = 15; r >= 0; --r) { const float zl = fminf(s1[r] * CS, 126.f); float sp = __builtin_amdgcn_logf(1.f + __builtin_amdgcn_exp2f(zl)); float ls = zl - sp + run1;
                    if (msk && (key0 + 32 + r >= qrow)) { sp = 0.f; ls = -1e30f; } s1[r] = ls; run1 -= sp; }
#pragma unroll
                for (int r = 15; r >= 0; --r) { const float zl = fminf(s0[r] * CS, 126.f); float sp = __builtin_amdgcn_logf(1.f + __builtin_amdgcn_exp2f(zl)); float ls = zl - sp + run0;
                    if (msk && (key0 + r >= qrow)) { sp = 0.f; ls = -1e30f; } s0[r] = ls; run0 -= sp; }
                const float oth1 = swap_other(run1, hh), oth0 = swap_other(run0, hh);
                const float base1 = carry + (hh == 0 ? oth1 : 0.f);
                const float base0 = carry + run1 + oth1 + (hh == 0 ? oth0 : 0.f);
                carry += (run1 + oth1) + (run0 + oth0);
#pragma unroll
                for (int r = 0; r < 16; ++r) { s1[r] = __builtin_amdgcn_exp2f(s1[r] + base1); s0[r] = __builtin_amdgcn_exp2f(s0[r] + base0); }
            } else {
                const bool msk = (64 * j + 63 > R0 + 32 * wid);
                if (msk) {
#pragma unroll
                    for (int r = 0; r < 16; ++r) { if (key0 + r > qrow) s0[r] = -1e30f; if (key0 + 32 + r > qrow) s1[r] = -1e30f; } }
                float mx = fmaxf(s0[0], s1[0]);
#pragma unroll
                for (int r = 1; r < 16; ++r) mx = fmaxf(mx, fmaxf(s0[r], s1[r]));
                mx = fmaxf(mx, swap_other(mx, hh));
                const float mn = fmaxf(carry, mx), alpha = __builtin_amdgcn_exp2f((carry - mn) * CS), mc = mn * CS; carry = mn;
                float ps = 0.f;
#pragma unroll
                for (int r = 0; r < 16; ++r) { s0[r] = __builtin_amdgcn_exp2f(s0[r] * CS - mc); s1[r] = __builtin_amdgcn_exp2f(s1[r] * CS - mc); ps += s0[r] + s1[r]; }
                lsum = lsum * alpha + ps;
#pragma unroll
                for (int r = 0; r < 16; ++r) { o0[r] *= alpha; o1[r] *= alpha; }
            }
#pragma unroll
            for (int t = 0; t < 8; ++t) { pw[0][t] = cvtpk(s0[2 * t], s0[2 * t + 1]); pw[1][t] = cvtpk(s1[2 * t], s1[2 * t + 1]); }
#pragma unroll
            for (int blk = 0; blk < 2; ++blk)
#pragma unroll
                for (int sx = 0; sx < 2; ++sx) {
                    const u32x4 pfu = {pw[blk][4 * sx], pw[blk][4 * sx + 1], pw[blk][4 * sx + 2], pw[blk][4 * sx + 3]}; const bf16x8 pf = __builtin_bit_cast(bf16x8, pfu);
#pragma unroll
                    for (int dblk = 0; dblk < 2; ++dblk) {
                        ATT_LAS unsigned char* vp = kb + vfr + (32 * blk + 16 * sx) * VSTR + 64 * dblk;
                        const s16x4 lo = __builtin_bit_cast(s16x4, __builtin_amdgcn_ds_read_tr16_b64_v4i16((ATT_LAS s16x4*)vp));
                        const s16x4 hi = __builtin_bit_cast(s16x4, __builtin_amdgcn_ds_read_tr16_b64_v4i16((ATT_LAS s16x4*)(vp + 8 * VSTR)));
                        const bf16x8 vf = {lo[0], lo[1], lo[2], lo[3], hi[0], hi[1], hi[2], hi[3]};
                        if (dblk == 0) o0 = __builtin_amdgcn_mfma_f32_32x32x16_bf16(vf, pf, o0, 0, 0, 0); else o1 = __builtin_amdgcn_mfma_f32_32x32x16_bf16(vf, pf, o1, 0, 0, 0);
                    }
                }
            if (SB) wdone = __all(carry < -160.f) != 0;
        }
        if (i + 1 < ntiles) ATT_WRITE(st ^ 1);
        if (SB) { if (lane == 0) flags[st * 8 + wid] = wdone ? 1 : 0; }
        __syncthreads();
        if (SB) { int all = 1;
#pragma unroll
            for (int w = 0; w < 8; ++w) all &= flags[st * 8 + w];
            if (all) break; }
    }
    float inv = 1.f;
    if (!SB) { const float lt = lsum + swap_other(lsum, hh); inv = 1.f / lt; }
    bf16* orow = P.HM + (row0 + qrow) * D + (SB ? 64 * h : 256 + 64 * h) + 4 * hh;
#pragma unroll
    for (int g = 0; g < 4; ++g) {
        u32x2 w0, w1; w0.x = cvtpk(o0[4 * g] * inv, o0[4 * g + 1] * inv); w0.y = cvtpk(o0[4 * g + 2] * inv, o0[4 * g + 3] * inv);
        w1.x = cvtpk(o1[4 * g] * inv, o1[4 * g + 1] * inv); w1.y = cvtpk(o1[4 * g + 2] * inv, o1[4 * g + 3] * inv);
        *(u32x2*)(orow + 8 * g) = w0; *(u32x2*)(orow + 32 + 8 * g) = w1; }
    __syncthreads();
#undef ATT_TILE
#undef ATT_LOAD
#undef ATT_WRITE
}
constexpr int N_ATT_UNITS = 768;
__device__ __forceinline__ void attn_run_unit(ATT_LAS unsigned char* lds, const AttnP& P, int u, int wave_s) {
    if (u < 512) { const int qb = 7 - (u >> 6), bh = u & 63; attn_unit<false>(lds, P, bh >> 3, bh & 7, qb, wave_s); }
    else { const int v = u - 512, qb = 7 - (v >> 5), bh = v & 31; attn_unit<true>(lds, P, bh >> 2, bh & 3, qb, wave_s); }
}
}

#define GAS __attribute__((address_space(1)))
#define LAS __attribute__((address_space(3)))
typedef GAS unsigned gu32;
#define RLX_AGENT __ATOMIC_RELAXED, __HIP_MEMORY_SCOPE_AGENT
#define XB_TMO      128
#define XB_XCNT(j)  (256  + 64 * (j))
#define XB_XSUB(j)  (1280 + 64 * (j))
#define XB_XGEN(j)  (2304 + 64 * (j))
#define XB_TOP      3328
#define XB_TOPGEN   3392
#define XCD_BAR_WORDS 3456
#define XB_SPIN_CAP (1u << 22)
__device__ __forceinline__ unsigned xb_ld(unsigned* p)              { return __hip_atomic_load(p, __ATOMIC_RELAXED, __HIP_MEMORY_SCOPE_AGENT); }
__device__ __forceinline__ unsigned xb_add(unsigned* p, unsigned v) { return __hip_atomic_fetch_add(p, v, __ATOMIC_RELAXED, __HIP_MEMORY_SCOPE_AGENT); }
__device__ __forceinline__ unsigned xb_xcc_id() { return (unsigned)__builtin_amdgcn_s_getreg((3 << 11) | 20) & 0xFu; }
#define XB_SPIN(cond, bar) do { unsigned _sp = 0; while (cond) { __builtin_amdgcn_s_sleep(1); \
    if ((++_sp & 255u) == 0u) { if (xb_ld(&(bar)[XB_TMO])) break; if (_sp > XB_SPIN_CAP) { atomicAdd(&(bar)[XB_TMO], 1u); break; } } } } while (0)
struct XcdBarrier { unsigned* bar; unsigned x; volatile LAS unsigned* st; };
__device__ __forceinline__ XcdBarrier xcd_barrier_post(unsigned* bar, volatile LAS unsigned* st) {
    XcdBarrier b; b.bar = bar; b.x = xb_xcc_id(); b.st = st;
    if (wave_id_s() == 0 && lane_id_v() == 0) (void)xb_add(&bar[XB_XCNT(b.x)], 1u);
    return b;
}
__device__ __forceinline__ void xcd_barrier_complete(unsigned* bar, unsigned x, unsigned& nloc, unsigned& nx) {
    const unsigned G = gridDim.x * gridDim.y * gridDim.z;
    unsigned sum, cnt, mine, sp = 0u;
    for (;;) {
        sum = 0u; cnt = 0u; mine = 0u;
#pragma unroll
        for (unsigned j = 0; j < 16; ++j) { const unsigned c = xb_ld(&bar[XB_XCNT(j)]); sum += c; cnt += (c > 0u) ? 1u : 0u; mine = (j == x) ? c : mine; }
        if (sum == G) break;
        __builtin_amdgcn_s_sleep(1);
        if ((++sp & 255u) == 0u) { if (xb_ld(&bar[XB_TMO])) break; if (sp > XB_SPIN_CAP) { atomicAdd(&bar[XB_TMO], 1u); break; } }
    }
    nloc = mine > 0u ? mine : 1u; nx = cnt > 0u ? cnt : 1u;
}
__device__ __forceinline__ void xcd_barrier(const XcdBarrier& b, int wave_s) {
    asm volatile("s_waitcnt vmcnt(0)" ::: "memory");
    __syncthreads();
    if (wave_s == 0 && lane_id_v() == 0) {
        unsigned* bar = b.bar; asm volatile("" : "+s"(bar));
        __builtin_amdgcn_s_waitcnt(0);
        unsigned nloc = b.st[0], nx = b.st[1];
        if (nloc == 0u) { xcd_barrier_complete(bar, b.x, nloc, nx); b.st[0] = nloc; b.st[1] = nx; }
        const unsigned old = xb_add(&bar[XB_XSUB(b.x)], 1u);
        const unsigned gen = old / nloc;
        if (old + 1u == (gen + 1u) * nloc) {
            __builtin_amdgcn_fence(__ATOMIC_RELEASE, "agent");
            asm volatile("s_waitcnt vmcnt(0)" ::: "memory");
            const unsigned og = xb_add(&bar[XB_TOP], 1u);
            const unsigned tg = og / nx;
            if (og + 1u == (tg + 1u) * nx) xb_add(&bar[XB_TOPGEN], 1u);
            else XB_SPIN(xb_ld(&bar[XB_TOPGEN]) == tg, bar);
            __builtin_amdgcn_fence(__ATOMIC_ACQUIRE, "agent");
            xb_add(&bar[XB_XGEN(b.x)], 1u);
            asm volatile("s_waitcnt vmcnt(0)" ::: "memory");
        } else {
            XB_SPIN(xb_ld(&bar[XB_XGEN(b.x)]) == gen, bar);
            __builtin_amdgcn_fence(__ATOMIC_ACQUIRE, "agent");
            asm volatile("s_waitcnt vmcnt(0)" ::: "memory");
        }
    }
    __syncthreads();
}

constexpr int RING_BYTES = 131072, LDSCTL_OFF = RING_BYTES, MISC_OFF = LDSCTL_OFF + 320, LDS_BYTES = 147456;
constexpr int CW_BAR = 4096, CW_ATT = 16384;
constexpr size_t CTL_ZERO_BYTES = 256 * 1024;

#define PA(f) (({ const __attribute__((address_space(4))) Ptrs* k_ = (const __attribute__((address_space(4))) Ptrs*)__builtin_amdgcn_kernarg_segment_ptr(); asm volatile("" : "+s"(k_)); k_; })->f)
__global__ void __launch_bounds__(512, 2) mega_fwd(Ptrs P) {
    extern __shared__ __attribute__((aligned(16))) unsigned char lds_raw[];
    LAS unsigned char* lds = (LAS unsigned char*)lds_raw;
    volatile LAS unsigned* MISC = (volatile LAS unsigned*)(lds + MISC_OFF);
    const int wave = wave_id_s();
#define lane lane_id_v()
#define tid (wave * 64 + lane_id_v())
    const int G = gridDim.x, bx = blockIdx.x, vcu = (G % 8 == 0) ? (bx % 8) * (G / 8) + bx / 8 : bx;
    unsigned char* ws = PA(ws);
    unsigned* ctl = (unsigned*)(ws + WS_CTL);
    for (int u = tid; u < (LDS_BYTES - LDSCTL_OFF) / 4; u += 512) ((LAS unsigned*)(lds + LDSCTL_OFF))[u] = 0u;
    __syncthreads();
    XcdBarrier bar = xcd_barrier_post(ctl + CW_BAR, MISC + 8);
#define GRID_BAR() do { int wv_ = wave; asm volatile("" : "+s"(wv_)); xcd_barrier(bar, wv_); } while (0)
#define WSL ({ unsigned char* w_ = PA(ws); asm volatile("" : "+s"(w_)); w_; })
#define WB ((bf16*)(WSL + WS_W))
#define HM ((bf16*)(WSL + WS_HM))
#define KR ((bf16*)(WSL + WS_KR))
#define IN ((bf16*)(WSL + WS_IN))
#define QM ((bf16*)(WSL + WS_QM))
#define KV ((bf16*)(WSL + WS_KV))
#define HID ((bf16*)(WSL + WS_HID))
#define Y ((bf16*)(WSL + WS_Y))
#define P16 ((bf16*)(WSL + WS_P16))
#define PP ((float*)(WSL + WS_PP))
#define SSQ ((float*)(WSL + WS_SSQ))
#define SSKV ((float*)(WSL + WS_SSKV))
#define RT ((float*)(WSL + WS_ROPE))
#define X ({ float* x_ = PA(out); asm volatile("" : "+s"(x_)); x_; })
    const int gw = vcu * 8 + wave, NGW = G * 8, NT = G * 512;
#define gt (bx * 512 + tid)

    {
        float* scr = (float*)(lds_raw + wave * 16384); bf16* const WB0 = WB; float* const RT0 = RT; float* const SS0 = SSQ; float* const X0 = X; bf16* const HM0 = HM;
        constexpr int I_G = (D / 64) * (FF / 32), I_D = (FF / 64) * (D / 32), I_IN = (D / 64) * (2208 / 32), I_UQ = (QRANK / 64) * (NQ / 32), I_UKV = (KVRANK / 64) * (NKV / 32),
                      I_O = (D / 64) * (D / 32), I_PP = (PLE / 64) * (D / 32);
        constexpr int I_LAYER = 6 * I_G + I_IN + I_UQ + I_UKV + 2 * I_O + I_PP;
        static_assert(I_G == I_D, "items");
        for (int it = gw; it < DEPTH * I_LAYER; it += NGW) {
            const int l = it / I_LAYER; int r = it % I_LAYER; bf16* wl = WB0 + (size_t)l * W_LAYER;
            const size_t oFF = (size_t)l * D * FF;
            if (r < I_G) { prep_item(PA(w1_gate) + oFF, D, FF, wl + WO_GU1, MAP_GATE, nullptr, scr, r, lane); continue; } r -= I_G;
            if (r < I_G) { prep_item(PA(w1_up) + oFF, D, FF, wl + WO_GU1, MAP_UP, nullptr, scr, r, lane); continue; } r -= I_G;
            if (r < I_D) { prep_item(PA(w1_down) + oFF, FF, D, wl + WO_D1, MAP_ID, nullptr, scr, r, lane); continue; } r -= I_D;
            if (r < I_G) { prep_item(PA(w2_gate) + oFF, D, FF, wl + WO_GU2, MAP_GATE, nullptr, scr, r, lane); continue; } r -= I_G;
            if (r < I_G) { prep_item(PA(w2_up) + oFF, D, FF, wl + WO_GU2, MAP_UP, nullptr, scr, r, lane); continue; } r -= I_G;
            if (r < I_D) { prep_item(PA(w2_down) + oFF, FF, D, wl + WO_D2, MAP_ID, nullptr, scr, r, lane); continue; } r -= I_D;
            if (r < I_IN) { prep_item(PA(w_in) + (size_t)l * D * 2208, D, 2208, wl + WO_IN, MAP_IN, nullptr, scr, r, lane); continue; } r -= I_IN;
            if (r < I_UQ) { prep_item(PA(w_mla_uq) + (size_t)l * QRANK * NQ, QRANK, NQ, wl + WO_UQ, MAP_UQ, PA(g_mla_q) + l * QRANK, scr, r, lane); continue; } r -= I_UQ;
            if (r < I_UKV) { prep_item(PA(w_mla_ukv) + (size_t)l * KVRANK * NKV, KVRANK, NKV, wl + WO_UKV, MAP_UKV, PA(g_mla_kv) + l * KVRANK, scr, r, lane); continue; } r -= I_UKV;
            if (r < I_O) { prep_item(PA(w_out) + (size_t)l * D * D, D, D, wl + WO_OUT, MAP_ID, nullptr, scr, r, lane); continue; } r -= I_O;
            if (r < I_O) { prep_item(PA(w_ple_gate) + (size_t)l * D * D, D, D, wl + WO_PG, MAP_ID, nullptr, scr, r, lane); continue; } r -= I_O;
            prep_item(PA(w_ple_proj) + (size_t)l * PLE * D, PLE, D, wl + WO_PP, MAP_ID, nullptr, scr, r, lane);
        }
        for (int i = gt; i < DEPTH * 96 * (D / 8); i += NT) { const int l = i / (96 * (D / 8)), r = i % (96 * (D / 8)); *(u32x4*)(WB0 + (size_t)l * W_LAYER + WO_IN + (size_t)(1184 + r / (D / 8)) * D + (r % (D / 8)) * 8) = (u32x4){0u, 0u, 0u, 0u}; }
        for (int i = gt; i < T * 16; i += NT) { const int t = i >> 4, j = i & 15; const double inv = pow(10000.0, -(double)j / 16.0); const double a = (double)PA(pos)[t] * inv; RT0[t * 32 + j] = (float)cos(a); RT0[t * 32 + 16 + j] = (float)sin(a); }
        for (int i = gt; i < 4 * T; i += NT) SS0[i] = 0.f;
        for (int m = gw; m < T; m += NGW) norm_row_first(PA(x) + (size_t)m * D, X0 + (size_t)m * D, HM0 + (size_t)m * D, PA(g_ffn1_pre), lane);
    }
    GRID_BAR();

#define GEMM_PHASE(EpiT, Aptr, lda_, Bptr, ldb_, N_, K_, ...) do { pg8::Gemm g_{Aptr, Bptr, T, N_, K_, lda_, ldb_, 0}; int bx_ = bx; asm volatile("" : "+s"(bx_)); pg8::StaticOrder S_; S_.init(T, N_, G, bx_); EpiT E_{__VA_ARGS__}; \
        int wv_ = wave; asm volatile("" : "+s"(wv_)); pg8::gemm_phase<EpiT, pg8::StaticOrder, true, true>(lds, g_, S_, E_, wv_); } while (0)
#define NORM_PHASE(w_, gpost_, gnext_) do { const bf16* y_ = Y; float* xx_ = X; bf16* hm_ = HM; int lane_ = lane, gw_ = gw; asm volatile("" : "+v"(lane_), "+s"(gw_)); for (int m = gw_; m < T; m += NGW) norm_row_step(y_ + (size_t)m * D, xx_ + (size_t)m * D, hm_ + (size_t)m * D, w_, gpost_, gnext_, lane_); } while (0)

#pragma unroll 1
    for (int l = 0; l < DEPTH; ++l) {
#define wl (WB + (size_t)l * W_LAYER)
        GEMM_PHASE(pg8::EpiGU, HM, D, wl + WO_GU1, D, NGU, D, HID, FF, 0);
        GRID_BAR();
        GEMM_PHASE(pg8::EpiStore<0>, HID, FF, wl + WO_D1, FF, D, FF, Y, nullptr, nullptr, nullptr, nullptr, D, 0.f);
        GRID_BAR();
        NORM_PHASE(0.5f, PA(g_ffn1_post) + l * D, PA(g_mix_pre) + l * D);
        GRID_BAR();
        GEMM_PHASE(pg8::EpiStore<1>, HM, D, wl + WO_IN, D, NIN, D, IN, SSQ + l * T, SSKV + l * T, nullptr, nullptr, NIN, 0.f);
        GRID_BAR();
        {
            const float* wconv = PA(w_conv) + l * 3 * 256; const bf16* const in_ = IN; const float* const rt_ = RT; bf16* const kr_ = KR; bf16* const hm_ = HM; int gt_ = gt; asm volatile("" : "+v"(gt_));
            for (int i = gt_; i < T * 16; i += NT) { const int t = i >> 4, j = i & 15; const float c = rt_[t * 32 + j], s = rt_[t * 32 + 16 + j];
                const float x1 = bf2f(in_[(size_t)t * NIN + IN_KR + j]), x2 = bf2f(in_[(size_t)t * NIN + IN_KR + 16 + j]);
                kr_[t * 32 + j] = (bf16)f2bf(x1 * c - x2 * s); kr_[t * 32 + 16 + j] = (bf16)f2bf(x2 * c + x1 * s); }
            for (int i = gt_; i < T * 256; i += NT) { const int t = i >> 8, c = i & 255, tt = t % SEQ; const bf16* r = in_ + (size_t)t * NIN; float acc = 0.f;
#pragma unroll
                for (int j = 0; j < 3; ++j) { const int dt = 2 - j; if (tt - dt >= 0) { const bf16* rr = r - (size_t)dt * NIN; acc += wconv[j * 256 + c] * (bf2f(rr[IN_CVC + c]) * bf2f(rr[IN_CVH + c])); } }
                hm_[(size_t)t * D + 768 + c] = (bf16)f2bf(bf2f(r[IN_CVB + c]) * acc); }
            GEMM_PHASE(pg8::EpiStore<2>, IN + IN_CQ, NIN, wl + WO_UQ, QRANK, NQ, QRANK, QM, nullptr, nullptr, SSQ + l * T, RT, NQ, (float)QRANK);
            GEMM_PHASE(pg8::EpiStore<3>, IN + IN_CKV, NIN, wl + WO_UKV, KVRANK, NKV, KVRANK, KV, nullptr, nullptr, SSKV + l * T, nullptr, NKV, (float)KVRANK);
        }
        GRID_BAR();
        {
            const att::AttnP AP{IN, QM, KV, KR, HM};
            for (;;) {
                if (tid == 0) { unsigned* c_ = (unsigned*)WSL; MISC[0] = xb_add(c_ + CW_ATT + 64 * l, 1u); }
                __syncthreads();
                const int u = (int)MISC[0];
                __syncthreads();
                if (u >= att::N_ATT_UNITS) break;
                { int wv_ = wave; asm volatile("" : "+s"(wv_)); att::attn_run_unit(lds, AP, u, wv_); }
            }
        }
        GRID_BAR();
        GEMM_PHASE(pg8::EpiStore<0>, HM, D, wl + WO_OUT, D, D, D, Y, nullptr, nullptr, nullptr, nullptr, D, 0.f);
        GRID_BAR();
        NORM_PHASE(1.0f, PA(g_mix_post) + l * D, PA(g_ffn2_pre) + l * D);
        GRID_BAR();
        GEMM_PHASE(pg8::EpiGU, HM, D, wl + WO_GU2, D, NGU, D, HID, FF, 0);
        GRID_BAR();
        GEMM_PHASE(pg8::EpiStore<0>, HID, FF, wl + WO_D2, FF, D, FF, Y, nullptr, nullptr, nullptr, nullptr, D, 0.f);
        GRID_BAR();
        NORM_PHASE(0.5f, PA(g_ffn2_post) + l * D, PA(g_ple_pre) + l * D);
        { const float* p = PA(p) + (size_t)l * T * PLE; bf16* const p16_ = P16; int gt_ = gt; asm volatile("" : "+v"(gt_));
          for (int i = gt_; i < T * PLE / 4; i += NT) { const f32x4 v = *(const f32x4*)(p + 4 * (size_t)i); u32x2 o; o.x = pk2(v.x, v.y); o.y = pk2(v.z, v.w); *(u32x2*)(p16_ + 4 * (size_t)i) = o; } }
        GRID_BAR();
        GEMM_PHASE(pg8::EpiPle<true>, P16, PLE, wl + WO_PP, PLE, D, PLE, PP, nullptr, D, 0);
        GEMM_PHASE(pg8::EpiPle<false>, HM, D, wl + WO_PG, D, D, D, PP, Y, D, 0);
        GRID_BAR();
        NORM_PHASE(1.0f, PA(g_ple_post) + l * D, (const float*)(l + 1 < DEPTH ? PA(g_ffn1_pre) + (l + 1) * D : nullptr));
        if (l + 1 < DEPTH) GRID_BAR();
    }
}

extern "C" void kernel_launch(void* const* d_in, const int* in_sizes, int n_in, void* d_out, int out_size, void* d_ws, size_t ws_size, hipStream_t stream) {
    static int grid = 0;
    if (grid == 0) {
        if (n_in != 26 || out_size != T * D || ws_size < WS_END) { fprintf(stderr, "kernel_launch: unexpected shapes n_in %d out %d ws %zu\n", n_in, out_size, ws_size); grid = -1; return; }
        int dev = 0, cus = 0, per_cu = 0;
        if (hipGetDevice(&dev) != hipSuccess || hipDeviceGetAttribute(&cus, hipDeviceAttributeMultiprocessorCount, dev) != hipSuccess) { grid = -1; return; }
        if (hipFuncSetAttribute((const void*)mega_fwd, hipFuncAttributeMaxDynamicSharedMemorySize, LDS_BYTES) != hipSuccess) { fprintf(stderr, "kernel_launch: hipFuncSetAttribute failed\n"); grid = -1; return; }
        if (hipOccupancyMaxActiveBlocksPerMultiprocessor(&per_cu, (const void*)mega_fwd, 512, LDS_BYTES) != hipSuccess || per_cu < 1) { fprintf(stderr, "kernel_launch: occupancy query says %d\n", per_cu); per_cu = 1; }
        (void)hipGetLastError();
        grid = cus;
    }
    if (grid < 0) return;
    if (hipMemsetAsync((char*)d_ws + WS_CTL, 0, CTL_ZERO_BYTES, stream) != hipSuccess) { fprintf(stderr, "kernel_launch: memset failed\n"); return; }
    Ptrs P{};
    P.x = (const float*)d_in[0]; P.p = (const float*)d_in[1]; P.pos = (const int*)d_in[2];
    const float** f = &P.g_ffn1_pre; for (int i = 0; i < 23; ++i) f[i] = (const float*)d_in[3 + i];
    P.out = (float*)d_out; P.ws = (unsigned char*)d_ws;
    void* args[] = {&P};
    hipError_t e = hipLaunchCooperativeKernel((const void*)mega_fwd, dim3(grid), dim3(512), args, LDS_BYTES, stream);
    if (e != hipSuccess) fprintf(stderr, "kernel_launch: cooperative launch failed: %s (grid %d)\n", hipGetErrorString(e), grid);
}
```
